# Optimizing an MI355X kernel written in HIP

```python
import math
import jax
import jax.numpy as jnp
from jax import lax
import numpy as np

D_MODEL = 2048
BATCH = 16
SEQ = 256
DEPTH = 4
DEC_BATCH = 8
DEC_SEQ = 2048
PAST_LEN = 512

GRID_W = 64
ROPE_THETA = 10000.0
EPS = 1e-6
Q_BLOCK = 128
N_MOD = 9
D_FF = 2 * D_MODEL

MLA_HEADS = 8
MLA_Q_RANK = D_MODEL // 4
MLA_KV_RANK = D_MODEL // 8
MLA_NOPE = 128
MLA_ROPE = 64
MLA_V = 128

S5_CH = D_MODEL // 4
S5_GROUP = 16
S5_GROUPS = S5_CH // S5_GROUP
S5_STATE = 64

GQA_Q_HEADS = 4
GQA_KV_HEADS = 2
GQA_HEAD_DIM = 128

MLA_IN = MLA_Q_RANK + MLA_KV_RANK + MLA_ROPE
GQA_IN = (GQA_Q_HEADS + 2 * GQA_KV_HEADS) * GQA_HEAD_DIM
D_IN = MLA_IN + S5_CH + GQA_IN
D_MIX = MLA_HEADS * MLA_V + S5_CH + GQA_Q_HEADS * GQA_HEAD_DIM
SPLIT_POINTS = (MLA_Q_RANK, MLA_Q_RANK + MLA_KV_RANK, MLA_IN, MLA_IN + S5_CH,
                MLA_IN + S5_CH + GQA_Q_HEADS * GQA_HEAD_DIM,
                MLA_IN + S5_CH + (GQA_Q_HEADS + GQA_KV_HEADS) * GQA_HEAD_DIM)
MLA_SCALE = 1.0 / math.sqrt(MLA_NOPE + MLA_ROPE)
GQA_SCALE = 1.0 / math.sqrt(GQA_HEAD_DIM)

kernel_name = "hymba_mla_s5_gqa_prefix_dit_step"


def rms_norm(x, g):
    xf = x.astype(jnp.float32)
    y = xf * lax.rsqrt(jnp.mean(xf * xf, axis=-1, keepdims=True) + EPS)
    return (y * g.astype(jnp.float32)).astype(x.dtype)


def modulate(x, g, shift, scale):
    return rms_norm(x, g) * (1.0 + scale) + shift


def swiglu(h, w_gate, w_up, w_down):
    return (jax.nn.silu(h @ w_gate) * (h @ w_up)) @ w_down


def modulation(cvec, w_ada, b_ada):
    m = jax.nn.silu(cvec) @ w_ada + b_ada
    return jnp.split(m, N_MOD, axis=-1)


def grid_angles(seq_len, rot_dim):
    n_rows = seq_len // GRID_W
    row = jnp.broadcast_to(jnp.arange(n_rows, dtype=jnp.float32)[:, None], (n_rows, GRID_W)).reshape(seq_len)
    col = jnp.broadcast_to(jnp.arange(GRID_W, dtype=jnp.float32)[None, :], (n_rows, GRID_W)).reshape(seq_len)
    n_freq = rot_dim // 4
    inv = ROPE_THETA ** (-jnp.arange(n_freq, dtype=jnp.float32) / n_freq)
    ang = jnp.concatenate([row[:, None] * inv, col[:, None] * inv], axis=-1)
    return jnp.cos(ang), jnp.sin(ang)


def apply_rope(x, cos, sin):
    half = x.shape[-1] // 2
    x1, x2 = x[..., :half], x[..., half:]
    c = cos[None, :, None, :].astype(x.dtype)
    s = sin[None, :, None, :].astype(x.dtype)
    return jnp.concatenate([x1 * c - x2 * s, x2 * c + x1 * s], axis=-1)


def attention(q, k, v, scale):
    b, sq, hq, dk = q.shape
    hkv = k.shape[2]
    rep = hq // hkv
    nblk = sq // Q_BLOCK
    qb = q.reshape(b, nblk, Q_BLOCK, hkv, rep, dk).transpose(1, 0, 2, 3, 4, 5)

    def one_block(qi):
        s = jnp.einsum('bqgrd,bkgd->bgrqk', qi, k, preferred_element_type=jnp.float32) * scale
        p = jax.nn.softmax(s, axis=-1)
        return jnp.einsum('bgrqk,bkgd->bqgrd', p.astype(v.dtype), v)

    o = lax.map(one_block, qb)
    return o.transpose(1, 0, 2, 3, 4, 5).reshape(b, sq, hq, v.shape[-1])


def mla_queries(zq, q_norm, w_uq, cos, sin):
    b, s, _ = zq.shape
    q = (rms_norm(zq, q_norm) @ w_uq).reshape(b, s, MLA_HEADS, MLA_NOPE + MLA_ROPE)
    q_nope, q_rope = q[..., :MLA_NOPE], q[..., MLA_NOPE:]
    if cos is not None:
        q_rope = apply_rope(q_rope, cos, sin)
    return jnp.concatenate([q_nope, q_rope], axis=-1)


def mla_keys_values(ckv, k_rope, w_ukv, cos, sin):
    b, s, _ = ckv.shape
    kv = (ckv @ w_ukv).reshape(b, s, MLA_HEADS, MLA_NOPE + MLA_V)
    k_nope, v = kv[..., :MLA_NOPE], kv[..., MLA_NOPE:]
    kr = k_rope[:, :, None, :]
    if cos is not None:
        kr = apply_rope(kr, cos, sin)
    k = jnp.concatenate([k_nope, jnp.broadcast_to(kr, (b, s, MLA_HEADS, MLA_ROPE))], axis=-1)
    return k, v


def s5_discretize(lam_re, lam_im, log_dt, b_re, b_im):
    dt = jnp.exp(log_dt.astype(jnp.float32))[:, None]
    lr = lam_re.astype(jnp.float32)
    li = lam_im.astype(jnp.float32)
    mag = jnp.exp(lr * dt)
    ab_re = mag * jnp.cos(li * dt)
    ab_im = mag * jnp.sin(li * dt)
    den = lr * lr + li * li
    nr = ab_re - 1.0
    f_re = (nr * lr + ab_im * li) / den
    f_im = (ab_im * lr - nr * li) / den
    br = b_re.astype(jnp.float32)
    bi = b_im.astype(jnp.float32)
    bb_re = f_re[..., None] * br - f_im[..., None] * bi
    bb_im = f_re[..., None] * bi + f_im[..., None] * br
    return ab_re, ab_im, bb_re, bb_im


def s5_combine(e1, e2):
    a1r, a1i, b1r, b1i = e1
    a2r, a2i, b2r, b2i = e2
    return (a1r * a2r - a1i * a2i, a1r * a2i + a1i * a2r,
            a2r * b1r - a2i * b1i + b2r, a2r * b1i + a2i * b1r + b2i)


def s5_scan(uf, ab_re, ab_im, bb_re, bb_im, h0, reverse):
    bu_re = jnp.einsum('gpc,bsgc->bsgp', bb_re, uf)
    bu_im = jnp.einsum('gpc,bsgc->bsgp', bb_im, uf)
    if h0 is not None:
        idx = -1 if reverse else 0
        bu_re = bu_re.at[:, idx].add(ab_re * h0[..., 0] - ab_im * h0[..., 1])
        bu_im = bu_im.at[:, idx].add(ab_re * h0[..., 1] + ab_im * h0[..., 0])
    a_re = jnp.broadcast_to(ab_re, bu_re.shape)
    a_im = jnp.broadcast_to(ab_im, bu_re.shape)
    _, _, hr, hi = lax.associative_scan(s5_combine, (a_re, a_im, bu_re, bu_im), axis=1, reverse=reverse)
    return hr, hi


def s5_mixer(u, lam_re, lam_im, log_dt, b_re, b_im, c_re, c_im, d_skip, w_glu, b_glu, h0, return_state):
    bsz, s, _ = u.shape
    uf = u.astype(jnp.float32).reshape(bsz, s, S5_GROUPS, S5_GROUP)
    y = d_skip.astype(jnp.float32).reshape(S5_GROUPS, S5_GROUP) * uf
    finals = []
    for dirn, reverse in ((0, False), (1, True)):
        ab_re, ab_im, bb_re, bb_im = s5_discretize(lam_re[dirn], lam_im[dirn], log_dt[dirn], b_re[dirn], b_im[dirn])
        init = None if h0 is None else h0[:, dirn].astype(jnp.float32)
        hr, hi = s5_scan(uf, ab_re, ab_im, bb_re, bb_im, init, reverse)
        y = y + jnp.einsum('gcp,bsgp->bsgc', c_re[dirn].astype(jnp.float32), hr) \
              - jnp.einsum('gcp,bsgp->bsgc', c_im[dirn].astype(jnp.float32), hi)
        if return_state:
            last = 0 if reverse else s - 1
            finals.append(jnp.stack([hr[:, last], hi[:, last]], axis=-1))
    y = y.reshape(bsz, s, S5_CH).astype(u.dtype)
    out = jax.nn.gelu(y) * jax.nn.sigmoid(y @ w_glu + b_glu)
    if return_state:
        return out, jnp.stack(finals, axis=1).astype(u.dtype)
    return out


def s5_params(lp):
    return (lp['s5_lambda_re'], lp['s5_lambda_im'], lp['s5_log_dt'], lp['s5_b_re'], lp['s5_b_im'],
            lp['s5_c_re'], lp['s5_c_im'], lp['s5_d'], lp['s5_w_glu'], lp['s5_b_glu'])


def mixer_context(h, lp):
    b, s, _ = h.shape
    zq, zkv, zkr, u, gq, gk, gv = jnp.split(h @ lp['w_in'], SPLIT_POINTS, axis=-1)
    ckv = rms_norm(zkv, lp['mla_kv_norm'])
    q = mla_queries(zq, lp['mla_q_norm'], lp['mla_w_uq'], None, None)
    k, v = mla_keys_values(ckv, zkr, lp['mla_w_ukv'], None, None)
    o_mla = attention(q, k, v, MLA_SCALE).reshape(b, s, MLA_HEADS * MLA_V)
    y_s5, s5_state = s5_mixer(u, *s5_params(lp), None, True)
    qg = rms_norm(gq.reshape(b, s, GQA_Q_HEADS, GQA_HEAD_DIM), lp['gqa_q_norm'])
    kg = rms_norm(gk.reshape(b, s, GQA_KV_HEADS, GQA_HEAD_DIM), lp['gqa_k_norm'])
    vg = gv.reshape(b, s, GQA_KV_HEADS, GQA_HEAD_DIM)
    o_gqa = attention(qg, kg, vg, GQA_SCALE).reshape(b, s, GQA_Q_HEADS * GQA_HEAD_DIM)
    out = jnp.concatenate([o_mla, y_s5, o_gqa], axis=-1) @ lp['w_out']
    return out, (ckv, zkr, kg, vg, s5_state)


def mixer_latent(h, ctx_ckv, ctx_krope, ctx_k, ctx_v, ctx_s5, lp):
    b, s, _ = h.shape
    cos_m, sin_m = grid_angles(s, MLA_ROPE)
    cos_g, sin_g = grid_angles(s, GQA_HEAD_DIM)
    zq, zkv, zkr, u, gq, gk, gv = jnp.split(h @ lp['w_in'], SPLIT_POINTS, axis=-1)
    q = mla_queries(zq, lp['mla_q_norm'], lp['mla_w_uq'], cos_m, sin_m)
    k_lat, v_lat = mla_keys_values(rms_norm(zkv, lp['mla_kv_norm']), zkr, lp['mla_w_ukv'], cos_m, sin_m)
    k_ctx, v_ctx = mla_keys_values(ctx_ckv, ctx_krope, lp['mla_w_ukv'], None, None)
    o_mla = attention(q, jnp.concatenate([k_ctx, k_lat], axis=1), jnp.concatenate([v_ctx, v_lat], axis=1),
                      MLA_SCALE).reshape(b, s, MLA_HEADS * MLA_V)
    y_s5 = s5_mixer(u, *s5_params(lp), ctx_s5, False)
    qg = apply_rope(rms_norm(gq.reshape(b, s, GQA_Q_HEADS, GQA_HEAD_DIM), lp['gqa_q_norm']), cos_g, sin_g)
    kg = apply_rope(rms_norm(gk.reshape(b, s, GQA_KV_HEADS, GQA_HEAD_DIM), lp['gqa_k_norm']), cos_g, sin_g)
    vg = gv.reshape(b, s, GQA_KV_HEADS, GQA_HEAD_DIM)
    o_gqa = attention(qg, jnp.concatenate([ctx_k, kg], axis=1), jnp.concatenate([ctx_v, vg], axis=1),
                      GQA_SCALE).reshape(b, s, GQA_Q_HEADS * GQA_HEAD_DIM)
    return jnp.concatenate([o_mla, y_s5, o_gqa], axis=-1) @ lp['w_out']


def trunk_layer(x, mods, lp, mix_fn):
    sh1, sc1, g1, sh2, sc2, g2, sh3, sc3, g3 = mods
    x = x + 0.5 * g1 * swiglu(modulate(x, lp['norm_ffn1'], sh1, sc1),
                              lp['ffn1_w_gate'], lp['ffn1_w_up'], lp['ffn1_w_down'])
    mixed, extra = mix_fn(modulate(x, lp['norm_mix'], sh2, sc2))
    x = x + g2 * mixed
    x = x + 0.5 * g3 * swiglu(modulate(x, lp['norm_ffn2'], sh3, sc3),
                              lp['ffn2_w_gate'], lp['ffn2_w_up'], lp['ffn2_w_down'])
    return x, extra


def setup_inputs(seed: int = 0) -> dict:
    key = jax.random.key(seed)
    ks = iter(jax.random.split(key, 64))

    def nrm(shape, std):
        return std * jax.random.normal(next(ks), shape, jnp.float32)

    def gain(shape):
        return 1.0 + nrm(shape, 0.05)

    L, D = DEPTH, D_MODEL
    G, P = S5_GROUPS, S5_STATE
    inp = {}
    inp['x_prompt'] = nrm((BATCH, SEQ, D), 1.0)
    inp['x_sample'] = nrm((DEC_BATCH, DEC_SEQ, D), 1.0)
    inp['cache_mla_ckv'] = nrm((DEC_BATCH, L, PAST_LEN, MLA_KV_RANK), 1.0)
    inp['cache_mla_krope'] = nrm((DEC_BATCH, L, PAST_LEN, MLA_ROPE), 1.0)
    inp['cache_gqa_k'] = nrm((DEC_BATCH, L, PAST_LEN, GQA_KV_HEADS, GQA_HEAD_DIM), 1.0)
    inp['cache_gqa_v'] = nrm((DEC_BATCH, L, PAST_LEN, GQA_KV_HEADS, GQA_HEAD_DIM), 1.0)
    inp['state_s5'] = nrm((DEC_BATCH, L, 2, G, P, 2), 0.3)
    inp['c'] = nrm((DEC_BATCH, D), 1.0)
    inp['c_ctx'] = nrm((D,), 1.0)
    inp['w_ada'] = nrm((L, D, N_MOD * D), 0.5 * D ** -0.5)
    inp['b_ada'] = nrm((L, N_MOD * D), 0.02)
    inp['norm_ffn1'] = gain((L, D))
    inp['ffn1_w_gate'] = nrm((L, D, D_FF), D ** -0.5)
    inp['ffn1_w_up'] = nrm((L, D, D_FF), D ** -0.5)
    inp['ffn1_w_down'] = nrm((L, D_FF, D), D_FF ** -0.5)
    inp['norm_mix'] = gain((L, D))
    inp['w_in'] = nrm((L, D, D_IN), D ** -0.5)
    inp['mla_q_norm'] = gain((L, MLA_Q_RANK))
    inp['mla_w_uq'] = nrm((L, MLA_Q_RANK, MLA_HEADS * (MLA_NOPE + MLA_ROPE)), MLA_Q_RANK ** -0.5)
    inp['mla_kv_norm'] = gain((L, MLA_KV_RANK))
    inp['mla_w_ukv'] = nrm((L, MLA_KV_RANK, MLA_HEADS * (MLA_NOPE + MLA_V)), MLA_KV_RANK ** -0.5)
    inp['s5_lambda_re'] = -0.5 + nrm((L, 2, G, P), 0.01)
    inp['s5_lambda_im'] = math.pi * jnp.arange(P, dtype=jnp.float32) + nrm((L, 2, G, P), 0.01)
    inp['s5_log_dt'] = jax.random.uniform(next(ks), (L, 2, G), jnp.float32, math.log(1e-3), math.log(1e-1))
    inp['s5_b_re'] = nrm((L, 2, G, P, S5_GROUP), (2 * S5_GROUP) ** -0.5)
    inp['s5_b_im'] = nrm((L, 2, G, P, S5_GROUP), (2 * S5_GROUP) ** -0.5)
    inp['s5_c_re'] = nrm((L, 2, G, S5_GROUP, P), (2 * P) ** -0.5)
    inp['s5_c_im'] = nrm((L, 2, G, S5_GROUP, P), (2 * P) ** -0.5)
    inp['s5_d'] = nrm((L, S5_CH), 0.5)
    inp['s5_w_glu'] = nrm((L, S5_CH, S5_CH), S5_CH ** -0.5)
    inp['s5_b_glu'] = nrm((L, S5_CH), 0.02)
    inp['gqa_q_norm'] = gain((L, GQA_HEAD_DIM))
    inp['gqa_k_norm'] = gain((L, GQA_HEAD_DIM))
    inp['w_out'] = nrm((L, D_MIX, D), D_MIX ** -0.5)
    inp['norm_ffn2'] = gain((L, D))
    inp['ffn2_w_gate'] = nrm((L, D, D_FF), D ** -0.5)
    inp['ffn2_w_up'] = nrm((L, D, D_FF), D ** -0.5)
    inp['ffn2_w_down'] = nrm((L, D_FF, D), D_FF ** -0.5)
    inp['norm_final'] = gain((D,))
    return inp


def reference(x_prompt, x_sample, cache_mla_ckv, cache_mla_krope, cache_gqa_k, cache_gqa_v, state_s5, c,
              c_ctx, w_ada, b_ada, norm_ffn1, ffn1_w_gate, ffn1_w_up, ffn1_w_down, norm_mix, w_in,
              mla_q_norm, mla_w_uq, mla_kv_norm, mla_w_ukv, s5_lambda_re, s5_lambda_im, s5_log_dt,
              s5_b_re, s5_b_im, s5_c_re, s5_c_im, s5_d, s5_w_glu, s5_b_glu, gqa_q_norm, gqa_k_norm,
              w_out, norm_ffn2, ffn2_w_gate, ffn2_w_up, ffn2_w_down, norm_final):
    xp = x_prompt
    xs = x_sample
    st_ckv, st_krope, st_k, st_v, st_s5 = [], [], [], [], []
    for l in range(DEPTH):
        lp = {
            'norm_ffn1': norm_ffn1[l], 'ffn1_w_gate': ffn1_w_gate[l], 'ffn1_w_up': ffn1_w_up[l],
            'ffn1_w_down': ffn1_w_down[l], 'norm_mix': norm_mix[l], 'w_in': w_in[l],
            'mla_q_norm': mla_q_norm[l], 'mla_w_uq': mla_w_uq[l], 'mla_kv_norm': mla_kv_norm[l],
            'mla_w_ukv': mla_w_ukv[l], 's5_lambda_re': s5_lambda_re[l], 's5_lambda_im': s5_lambda_im[l],
            's5_log_dt': s5_log_dt[l], 's5_b_re': s5_b_re[l], 's5_b_im': s5_b_im[l], 's5_c_re': s5_c_re[l],
            's5_c_im': s5_c_im[l], 's5_d': s5_d[l], 's5_w_glu': s5_w_glu[l], 's5_b_glu': s5_b_glu[l],
            'gqa_q_norm': gqa_q_norm[l], 'gqa_k_norm': gqa_k_norm[l], 'w_out': w_out[l],
            'norm_ffn2': norm_ffn2[l], 'ffn2_w_gate': ffn2_w_gate[l], 'ffn2_w_up': ffn2_w_up[l],
            'ffn2_w_down': ffn2_w_down[l],
        }
        mods_ctx = modulation(c_ctx, w_ada[l], b_ada[l])
        xp, (ckv, krope, kg, vg, s5s) = trunk_layer(xp, mods_ctx, lp, lambda hm: mixer_context(hm, lp))
        st_ckv.append(ckv)
        st_krope.append(krope)
        st_k.append(kg)
        st_v.append(vg)
        st_s5.append(s5s)
        mods_lat = [m[:, None, :] for m in modulation(c, w_ada[l], b_ada[l])]
        xs, _ = trunk_layer(
            xs, mods_lat, lp,
            lambda hm: (mixer_latent(hm, cache_mla_ckv[:, l], cache_mla_krope[:, l], cache_gqa_k[:, l],
                                     cache_gqa_v[:, l], state_s5[:, l], lp), None))
    y_prompt = rms_norm(xp, norm_final)
    y_sample = rms_norm(xs, norm_final)
    new_mla_ckv = jnp.stack(st_ckv, axis=1)
    new_mla_krope = jnp.stack(st_krope, axis=1)
    new_gqa_k = jnp.stack(st_k, axis=1)
    new_gqa_v = jnp.stack(st_v, axis=1)
    new_state_s5 = jnp.stack(st_s5, axis=1)
    return (y_prompt, y_sample, new_mla_ckv, new_mla_krope, new_gqa_k, new_gqa_v, new_state_s5)
```

```cpp
#include <hip/hip_runtime.h>
#include <hip/hip_bf16.h>
#include <cstdio>
#include <cstdint>
#include <cmath>
#ifndef DBG_CHECK
#define DBG_CHECK 0
#endif
__device__ __forceinline__ int lane_fresh() { int l; asm volatile("v_mbcnt_lo_u32_b32 %0, -1, 0\n\tv_mbcnt_hi_u32_b32 %0, -1, %0" : "=v"(l)); return l; }
namespace pg8 {
#define PG8_LAS __attribute__((address_space(3)))
typedef unsigned short bf16_t;
typedef short bf16x8 __attribute__((ext_vector_type(8)));
typedef float f32x4 __attribute__((ext_vector_type(4)));
typedef unsigned u32x4 __attribute__((ext_vector_type(4)));
constexpr int BM = 256, BK = 64, HALF = 128, HTB = HALF * BK * 2  , STAGE_BYTES = 8 * HTB, NXCD = 8, WGM = 8;

__host__ __device__ __forceinline__ int lds_byte(int r, int c) { const int st = (r >> 4) * 2 + (c >> 5), rr = r & 15, cc = c & 31, ob = rr * 64 + cc * 2; return st * 1024 + (ob ^ (((ob >> 9) & 1) << 5)); }
__host__ __device__ __forceinline__ void stage_rc(int b, int& R, int& C) { const int st = b / 1024, sb = b % 1024, swz = sb ^ (((sb >> 9) & 1) << 5); R = (st >> 1) * 16 + swz / 64; C = (st & 1) * 32 + (swz % 64) / 2; }
__host__ __device__ __forceinline__ int perm32(int rho) { const int n = rho >> 4, i = rho & 15; return 8 * (i >> 2) + 4 * n + (i & 3); }

struct Unit { int pm, pn; };
struct Gemm { const bf16_t* A; const bf16_t* Bt; int M, N, K; };

struct StaticOrder {
    int nM, nN, nwg, G, c;
    __host__ __device__ void init(int M, int N, int G_, int c_) { nM = M / BM; nN = N / BM; nwg = nM * nN; G = G_; c = c_; }
    __host__ __device__ bool next(int i, Unit& u) const {
        const long L = (long)i * G + c; if (L >= nwg) return false;
        int wgid = (int)L; { const int q = nwg / NXCD, r = nwg % NXCD, xcd = wgid % NXCD, off = wgid / NXCD; wgid = (xcd < r ? xcd * (q + 1) : r * (q + 1) + (xcd - r) * q) + off; }
        const int nig = WGM * nN, gid = wgid / nig, fm = gid * WGM, gsz = (nM - fm) < WGM ? (nM - fm) : WGM;
        u.pm = fm + ((wgid % nig) % gsz); u.pn = (wgid % nig) / gsz; return true;
    }
    __device__ __forceinline__ void a_ready(const Unit&) const {}
    __device__ __forceinline__ void done(const Unit&) const {}
};

__device__ __forceinline__ unsigned cvt_pk_bf16(float lo, float hi) { unsigned r; asm volatile("v_cvt_pk_bf16_f32 %0, %1, %2" : "=v"(r) : "v"(lo), "v"(hi)); return r; }
__device__ __forceinline__ float bf_lo(unsigned w) { return __uint_as_float(w << 16); }
__device__ __forceinline__ float bf_hi(unsigned w) { return __uint_as_float(w & 0xffff0000u); }
__device__ __forceinline__ float fast_sigmoid(float x) { return __builtin_amdgcn_rcpf(1.0f + __builtin_amdgcn_exp2f(-1.4426950408889634f * x)); }
__device__ __forceinline__ int req_of_pm(int pm) { return pm < 16 ? 0 : 1 + ((pm - 16) >> 3); }
constexpr int MODN = 9 * 2048;

struct EpiF32 {
    static constexpr bool PERM = false, AFTER_DRAIN = false;
    float* C; int ldc;
    __device__ __forceinline__ void operator()(const f32x4 (&acc)[2][2][4][2], const Unit& u, int wr, int wc, int fr, int fq) const {
        const int row0 = u.pm * BM + wr * 64 + fr, col0 = u.pn * BM + wc * 32 + 4 * fq;
#pragma unroll
        for (int ai = 0; ai < 2; ++ai)
#pragma unroll
            for (int m = 0; m < 4; ++m) { float* rowp = C + (size_t)(row0 + ai * HALF + m * 16) * ldc + col0;
#pragma unroll
                for (int bj = 0; bj < 2; ++bj)
#pragma unroll
                    for (int n = 0; n < 2; ++n) *(f32x4*)(rowp + bj * HALF + n * 16) = acc[ai][bj][m][n]; }
    }
};
struct EpiBf16 {
    static constexpr bool PERM = true, AFTER_DRAIN = false;
    bf16_t* O; int ldc;
    __device__ __forceinline__ void operator()(const f32x4 (&acc)[2][2][4][2], const Unit& u, int wr, int wc, int fr, int fq) const {
        const int row0 = u.pm * BM + wr * 64 + fr, col0 = u.pn * BM + wc * 32 + 8 * fq;
#pragma unroll
        for (int ai = 0; ai < 2; ++ai)
#pragma unroll
            for (int m = 0; m < 4; ++m) { bf16_t* rowp = O + (size_t)(row0 + ai * HALF + m * 16) * ldc + col0;
#pragma unroll
                for (int bj = 0; bj < 2; ++bj) { const f32x4 v0 = acc[ai][bj][m][0], v1 = acc[ai][bj][m][1];
                    u32x4 w; w.x = cvt_pk_bf16(v0[0], v0[1]); w.y = cvt_pk_bf16(v0[2], v0[3]); w.z = cvt_pk_bf16(v1[0], v1[1]); w.w = cvt_pk_bf16(v1[2], v1[3]);
                    *(u32x4*)(rowp + bj * HALF) = w; } }
    }
};
struct EpiSwiglu {
    static constexpr bool PERM = true, AFTER_DRAIN = false;
    bf16_t* O; int ldc;
    __device__ __forceinline__ void operator()(const f32x4 (&acc)[2][2][4][2], const Unit& u, int wr, int wc, int fr, int fq) const {
        const int row0 = u.pm * BM + wr * 64 + fr, col0 = u.pn * HALF + wc * 32 + 8 * fq;
#pragma unroll
        for (int ai = 0; ai < 2; ++ai)
#pragma unroll
            for (int m = 0; m < 4; ++m) { bf16_t* rowp = O + (size_t)(row0 + ai * HALF + m * 16) * ldc + col0;
                float r[8];
#pragma unroll
                for (int n = 0; n < 2; ++n)
#pragma unroll
                    for (int e = 0; e < 4; ++e) { const float g = acc[ai][0][m][n][e], up = acc[ai][1][m][n][e]; r[4 * n + e] = g * fast_sigmoid(g) * up; }
                u32x4 w; w.x = cvt_pk_bf16(r[0], r[1]); w.y = cvt_pk_bf16(r[2], r[3]); w.z = cvt_pk_bf16(r[4], r[5]); w.w = cvt_pk_bf16(r[6], r[7]);
                *(u32x4*)rowp = w; }
    }
};
struct EpiResid {
    static constexpr bool PERM = false, AFTER_DRAIN = false;
    const float* base_a; const float* base_b; float* out; const float* gate; float coef;
    __device__ __forceinline__ void operator()(const f32x4 (&acc)[2][2][4][2], const Unit& u, int wr, int wc, int fr, int fq) const {
        const int row0 = u.pm * BM + wr * 64 + fr, col0 = u.pn * BM + wc * 32 + 4 * fq;
        const float* g = gate + (size_t)req_of_pm(u.pm) * MODN + col0; const float* base = u.pm < 16 ? base_a : base_b;
        f32x4 gv[2][2];
#pragma unroll
        for (int bj = 0; bj < 2; ++bj)
#pragma unroll
            for (int n = 0; n < 2; ++n) gv[bj][n] = *(const f32x4*)(g + bj * HALF + n * 16) * coef;
#pragma unroll
        for (int ai = 0; ai < 2; ++ai)
#pragma unroll
            for (int m = 0; m < 4; ++m) { const size_t off = (size_t)(row0 + ai * HALF + m * 16) * 2048 + col0;
#pragma unroll
                for (int bj = 0; bj < 2; ++bj)
#pragma unroll
                    for (int n = 0; n < 2; ++n) *(f32x4*)(out + off + bj * HALF + n * 16) = *(const f32x4*)(base + off + bj * HALF + n * 16) + gv[bj][n] * acc[ai][bj][m][n]; }
    }
};
struct EpiQ {
    static constexpr bool PERM = true, AFTER_DRAIN = false;
    bf16_t* O; const float* cosm; const float* sinm;
    __device__ __forceinline__ void operator()(const f32x4 (&acc)[2][2][4][2], const Unit& u, int wr, int wc, int fr, int fq) const {
        const int row0 = u.pm * BM + wr * 64 + fr, col0 = u.pn * BM + wc * 32 + 8 * fq;
#pragma unroll
        for (int ai = 0; ai < 2; ++ai)
#pragma unroll
            for (int m = 0; m < 4; ++m) { const int row = row0 + ai * HALF + m * 16; const int t = (row - 4096) & 2047; bf16_t* rowp = O + (size_t)row * 1536 + col0;
#pragma unroll
                for (int bj = 0; bj < 2; ++bj) { f32x4 v0 = acc[ai][bj][m][0], v1 = acc[ai][bj][m][1];
                    const int cc = (col0 + bj * HALF) % 192;
                    if (cc >= 128 && row >= 4096) { const int j0 = (cc - 128) >> 1;
                        const f32x4 cs = *(const f32x4*)(cosm + t * 32 + j0), sn = *(const f32x4*)(sinm + t * 32 + j0);
                        const f32x4 a = v0, b = v1;
                        v0[0] = a[0] * cs[0] - a[1] * sn[0]; v0[1] = a[1] * cs[0] + a[0] * sn[0];
                        v0[2] = a[2] * cs[1] - a[3] * sn[1]; v0[3] = a[3] * cs[1] + a[2] * sn[1];
                        v1[0] = b[0] * cs[2] - b[1] * sn[2]; v1[1] = b[1] * cs[2] + b[0] * sn[2];
                        v1[2] = b[2] * cs[3] - b[3] * sn[3]; v1[3] = b[3] * cs[3] + b[2] * sn[3]; }
                    u32x4 w; w.x = cvt_pk_bf16(v0[0], v0[1]); w.y = cvt_pk_bf16(v0[2], v0[3]); w.z = cvt_pk_bf16(v1[0], v1[1]); w.w = cvt_pk_bf16(v1[2], v1[3]);
                    *(u32x4*)(rowp + bj * HALF) = w; } }
    }
};
struct EpiGlu {
    static constexpr bool PERM = true, AFTER_DRAIN = false;
    const bf16_t* Y; const float* bias; bf16_t* O; int ldo; int ocol0;
    __device__ __forceinline__ void operator()(const f32x4 (&acc)[2][2][4][2], const Unit& u, int wr, int wc, int fr, int fq) const {
        const int row0 = u.pm * BM + wr * 64 + fr, col0 = u.pn * BM + wc * 32 + 8 * fq;
#pragma unroll
        for (int ai = 0; ai < 2; ++ai)
#pragma unroll
            for (int m = 0; m < 4; ++m) { const int row = row0 + ai * HALF + m * 16;
#pragma unroll
                for (int bj = 0; bj < 2; ++bj) { const int c0 = col0 + bj * HALF;
                    const u32x4 yw = *(const u32x4*)(Y + (size_t)row * 512 + c0);
                    const f32x4 b0 = *(const f32x4*)(bias + c0), b1 = *(const f32x4*)(bias + c0 + 4);
                    const float yv[8] = {bf_lo(yw.x), bf_hi(yw.x), bf_lo(yw.y), bf_hi(yw.y), bf_lo(yw.z), bf_hi(yw.z), bf_lo(yw.w), bf_hi(yw.w)};
                    float r[8];
#pragma unroll
                    for (int e = 0; e < 8; ++e) { const float s = (e < 4 ? acc[ai][bj][m][0][e & 3] + b0[e & 3] : acc[ai][bj][m][1][e & 3] + b1[e & 3]);
                        const float y = yv[e]; const float a2 = 1.5957691216057308f * (y + 0.044715f * y * y * y);
                        r[e] = y * fast_sigmoid(a2) * fast_sigmoid(s); }
                    u32x4 w; w.x = cvt_pk_bf16(r[0], r[1]); w.y = cvt_pk_bf16(r[2], r[3]); w.z = cvt_pk_bf16(r[4], r[5]); w.w = cvt_pk_bf16(r[6], r[7]);
                    *(u32x4*)(O + (size_t)row * ldo + ocol0 + c0) = w; } }
    }
};

template <class Epi, class Sched, bool ALIGN_EPI = false, bool SP2 = false>
__device__ __forceinline__ void gemm_phase(PG8_LAS unsigned char* lds, const Gemm g, const Sched& S, const Epi& E, const int wv  ) {
    const int tid_ = (wv << 6) | lane_fresh();
    const int tid = tid_, wid = __builtin_amdgcn_readfirstlane(tid >> 6), lane = tid & 63, wr = wid >> 2, wc = wid & 3, fr = lane & 15, fq = lane >> 4;
    const int K = g.K, nt = K / BK;
    unsigned voffA[2], voffB[2];
#pragma unroll
    for (int i = 0; i < 2; ++i) { int R, C; stage_rc(tid * 16 + i * 8192, R, C); const int Rb = Epi::PERM ? ((R & ~31) + perm32(R & 31)) : R;
        voffA[i] = (unsigned)(R * K + C) * 2u; voffB[i] = (unsigned)(Rb * K + C) * 2u; }
    const size_t kstep = (size_t)(BK * 2);
    const size_t hstep = (size_t)HALF * K * 2;
    const size_t tstep = 2 * hstep;
    const unsigned ldsw = (unsigned)wid * 1024u;
    const int aoff = lds_byte(wr * 64 + fr, fq * 8), boff = lds_byte(wc * 32 + fr, fq * 8);
#define PG8_SA(b, h) (((b) * 2 + (h)) * HTB)
#define PG8_SB(b, h) ((4 + (b) * 2 + (h)) * HTB)
#define PG8_STAGE(bufoff, gbase, voff) do { _Pragma("unroll") for (int _i = 0; _i < 2; ++_i) \
        __builtin_amdgcn_global_load_lds((const unsigned*)((const char*)(gbase) + (voff)[_i]), (PG8_LAS unsigned*)(lds + (bufoff) + ldsw + _i * 8192), 16, 0, 0); } while (0)
#define PG8_LDA(dst, b, h) do { _Pragma("unroll") for (int m = 0; m < 4; ++m) _Pragma("unroll") for (int k = 0; k < 2; ++k) dst[m][k] = *(const PG8_LAS bf16x8*)(lds + PG8_SA(b, h) + aoff + m * 2048 + k * 1024); } while (0)
#define PG8_LDB(dst, b, h) do { _Pragma("unroll") for (int n = 0; n < 2; ++n) _Pragma("unroll") for (int k = 0; k < 2; ++k) dst[n][k] = *(const PG8_LAS bf16x8*)(lds + PG8_SB(b, h) + boff + n * 2048 + k * 1024); } while (0)
#define PG8_MMA(ai, bj, At, Bt) do { __builtin_amdgcn_s_setprio(1); _Pragma("unroll") for (int m = 0; m < 4; ++m) _Pragma("unroll") for (int n = 0; n < 2; ++n) _Pragma("unroll") for (int k = 0; k < 2; ++k) \
        acc[ai][bj][m][n] = __builtin_amdgcn_mfma_f32_16x16x32_bf16(Bt[n][k], At[m][k], acc[ai][bj][m][n], 0, 0, 0); __builtin_amdgcn_s_setprio(0); } while (0)
#define PG8_WAIT_V(n) asm volatile("s_waitcnt vmcnt(" #n ")" ::: "memory")
#define PG8_WAIT_L(n) asm volatile("s_waitcnt lgkmcnt(" #n ")" ::: "memory")
#define PG8_BAR __builtin_amdgcn_s_barrier()
#define PG8_SCHED __builtin_amdgcn_sched_barrier(0)
    Unit cur, nxt; int ui = 0;
    if (!S.next(0, cur)) return;
    f32x4 acc[2][2][4][2];
#pragma unroll
    for (int a = 0; a < 2; ++a)
#pragma unroll
        for (int b = 0; b < 2; ++b)
#pragma unroll
            for (int m = 0; m < 4; ++m)
#pragma unroll
                for (int n = 0; n < 2; ++n) acc[a][b][m][n] = (f32x4){0.f, 0.f, 0.f, 0.f};
    bf16x8 At[4][2], B0[2][2], B1[2][2];
    const char* cA = (const char*)g.A + (size_t)cur.pm * tstep; const char* cB = (const char*)g.Bt + (size_t)cur.pn * tstep;
    S.a_ready(cur);
    if constexpr (SP2) {
        PG8_STAGE(PG8_SB(0, 0), cB, voffB); PG8_STAGE(PG8_SB(0, 1), cB + hstep, voffB); PG8_STAGE(PG8_SA(0, 0), cA, voffA); PG8_STAGE(PG8_SA(0, 1), cA + hstep, voffA);
        if (wr == 1) PG8_BAR;
        PG8_WAIT_V(2); PG8_BAR;
        PG8_STAGE(PG8_SB(1, 0), cB + kstep, voffB); PG8_STAGE(PG8_SA(1, 0), cA + kstep, voffA); PG8_STAGE(PG8_SB(1, 1), cB + hstep + kstep, voffB);
        PG8_WAIT_V(6); PG8_BAR;
    } else {
        PG8_STAGE(PG8_SB(0, 0), cB, voffB); PG8_STAGE(PG8_SA(0, 0), cA, voffA); PG8_STAGE(PG8_SB(0, 1), cB + hstep, voffB); PG8_STAGE(PG8_SA(0, 1), cA + hstep, voffA);
        if (wr == 1) PG8_BAR;
        PG8_WAIT_V(4); PG8_BAR;
        PG8_STAGE(PG8_SB(1, 0), cB + kstep, voffB); PG8_STAGE(PG8_SA(1, 0), cA + kstep, voffA); PG8_STAGE(PG8_SB(1, 1), cB + hstep + kstep, voffB);
        PG8_WAIT_V(6); PG8_BAR;
    }
    for (;;) {
        const bool has_next = S.next(ui + 1, nxt);
        const char* nA = has_next ? (const char*)g.A + (size_t)nxt.pm * tstep : cA; const char* nB = has_next ? (const char*)g.Bt + (size_t)nxt.pn * tstep : cB;
        for (int t = 0; t < nt; t += 2) {
            const bool last = (t == nt - 2);
            const char* a1 = cA + (size_t)(t + 1) * kstep;
            const char* a2 = last ? nA : cA + (size_t)(t + 2) * kstep; const char* b2 = last ? nB : cB + (size_t)(t + 2) * kstep;
            const char* a3 = a2 + kstep; const char* b3 = b2 + kstep;
            if (last && has_next) S.a_ready(nxt);
            if constexpr (SP2) {
            PG8_LDB(B0, 0, 0); PG8_LDB(B1, 0, 1); PG8_SCHED; PG8_LDA(At, 0, 0); PG8_STAGE(PG8_SA(1, 1), a1 + hstep, voffA);
            PG8_WAIT_V(8); PG8_WAIT_L(0); PG8_BAR; PG8_MMA(0, 0, At, B0); PG8_MMA(0, 1, At, B1); PG8_BAR; PG8_SCHED;
            PG8_LDA(At, 0, 1); PG8_STAGE(PG8_SB(0, 0), b2, voffB); PG8_STAGE(PG8_SB(0, 1), b2 + hstep, voffB); PG8_STAGE(PG8_SA(0, 0), a2, voffA);
            PG8_WAIT_V(8); PG8_WAIT_L(0); PG8_BAR; PG8_MMA(1, 0, At, B0); PG8_MMA(1, 1, At, B1); PG8_BAR; PG8_SCHED;
            PG8_LDB(B0, 1, 0); PG8_LDB(B1, 1, 1); PG8_SCHED; PG8_LDA(At, 1, 0); PG8_STAGE(PG8_SA(0, 1), a2 + hstep, voffA);
            PG8_WAIT_V(8); PG8_WAIT_L(0); PG8_BAR; PG8_MMA(0, 0, At, B0); PG8_MMA(0, 1, At, B1); PG8_BAR; PG8_SCHED;
            PG8_LDA(At, 1, 1); PG8_STAGE(PG8_SB(1, 0), b3, voffB); PG8_STAGE(PG8_SB(1, 1), b3 + hstep, voffB); PG8_STAGE(PG8_SA(1, 0), a3, voffA);
            PG8_WAIT_V(8); PG8_WAIT_L(0); PG8_BAR; PG8_MMA(1, 0, At, B0); PG8_MMA(1, 1, At, B1); PG8_BAR; PG8_SCHED;
            } else {
            PG8_LDB(B0, 0, 0); PG8_SCHED; PG8_LDA(At, 0, 0); PG8_STAGE(PG8_SA(1, 1), a1 + hstep, voffA);
            PG8_WAIT_L(8); PG8_BAR; PG8_WAIT_L(0); PG8_MMA(0, 0, At, B0); PG8_BAR; PG8_SCHED;
            PG8_LDB(B1, 0, 1); PG8_STAGE(PG8_SB(0, 0), b2, voffB);
            PG8_BAR; PG8_WAIT_L(0); PG8_MMA(0, 1, At, B1); PG8_BAR;
            PG8_LDA(At, 0, 1); PG8_STAGE(PG8_SA(0, 0), a2, voffA);
            PG8_BAR; PG8_WAIT_L(0); PG8_MMA(1, 0, At, B0); PG8_BAR; PG8_SCHED;
            PG8_STAGE(PG8_SB(0, 1), b2 + hstep, voffB);
            PG8_WAIT_V(6); PG8_BAR; PG8_MMA(1, 1, At, B1); PG8_BAR;
            PG8_LDB(B0, 1, 0); PG8_SCHED; PG8_LDA(At, 1, 0); PG8_STAGE(PG8_SA(0, 1), a2 + hstep, voffA);
            PG8_WAIT_L(8); PG8_BAR; PG8_WAIT_L(0); PG8_MMA(0, 0, At, B0); PG8_BAR; PG8_SCHED;
            PG8_LDB(B1, 1, 1); PG8_STAGE(PG8_SB(1, 0), b3, voffB);
            PG8_BAR; PG8_WAIT_L(0); PG8_MMA(0, 1, At, B1); PG8_BAR;
            PG8_LDA(At, 1, 1); PG8_STAGE(PG8_SA(1, 0), a3, voffA);
            PG8_BAR; PG8_WAIT_L(0); PG8_MMA(1, 0, At, B0); PG8_BAR; PG8_SCHED;
            PG8_STAGE(PG8_SB(1, 1), b3 + hstep, voffB);
            PG8_WAIT_V(6); PG8_BAR; PG8_MMA(1, 1, At, B1); PG8_BAR;
            }
        }
        if constexpr (ALIGN_EPI) { if (wr == 0) PG8_BAR; }
        if constexpr (!Epi::AFTER_DRAIN) { const int l2_ = lane_fresh();
            E(acc, cur, wr, wc, l2_ & 15, l2_ >> 4); S.done(cur); }
        if (!has_next) break;
#pragma unroll
        for (int a = 0; a < 2; ++a)
#pragma unroll
            for (int b = 0; b < 2; ++b)
#pragma unroll
                for (int m = 0; m < 4; ++m)
#pragma unroll
                    for (int n = 0; n < 2; ++n) acc[a][b][m][n] = (f32x4){0.f, 0.f, 0.f, 0.f};
        cur = nxt; cA = nA; cB = nB; ++ui;
        if constexpr (ALIGN_EPI) { if (wr == 1) PG8_BAR; }
    }
    PG8_WAIT_V(0);
    if constexpr (!ALIGN_EPI) { if (wr == 0) PG8_BAR; }
    PG8_BAR;
    if constexpr (Epi::AFTER_DRAIN) { E.fused(acc, cur, wr, wc, fr, fq, lds, wid, lane); S.done(cur); }
#undef PG8_SA
#undef PG8_SB
#undef PG8_STAGE
#undef PG8_LDA
#undef PG8_LDB
#undef PG8_MMA
#undef PG8_WAIT_V
#undef PG8_WAIT_L
#undef PG8_BAR
#undef PG8_SCHED
}
}
namespace att {
using bf16x8 = __attribute__((ext_vector_type(8))) short;
using s16x4  = __attribute__((ext_vector_type(4))) short;
using f32x16 = __attribute__((ext_vector_type(16))) float;
using u32x4  = __attribute__((ext_vector_type(4))) unsigned;
typedef unsigned short bf16;
constexpr int DV = 128, NW = 8, QBLK = 32, KVBLK = 64;
constexpr float THR = 8.f;
constexpr size_t SHM_V = KVBLK * DV * 2;
template <int DK> constexpr size_t shm_k() { return (size_t)KVBLK * DK * 2; }
template <int DK> constexpr size_t shm_attn() { return 2 * SHM_V + 2 * shm_k<DK>() + NW * 64 * 4; }
#define ATT_KSWZ(row, colB, DKB) ((row) * (DKB) + ((colB) ^ (((row) & 7) << 4)))
#define ATT_SBAR() __builtin_amdgcn_sched_barrier(0)
__device__ __forceinline__ int crow(int r, int hi) { return (r & 3) + 8 * (r >> 2) + 4 * hi; }
__device__ __forceinline__ unsigned cvtpk(float lo, float hi) { unsigned r; asm volatile("v_cvt_pk_bf16_f32 %0, %1, %2" : "=v"(r) : "v"(lo), "v"(hi)); return r; }
__device__ __forceinline__ bf16x8 ld8(const bf16* p) { return *reinterpret_cast<const bf16x8*>(p); }

template <int DK> __device__ __forceinline__ void partialSM(f32x16& p0, f32x16& p1, float& m_reg, float& mn, float& alpha) {
  constexpr float SCALE = (DK == 192) ? 0.07216878364870322f : 0.08838834764831845f;
  constexpr float C = SCALE * 1.4426950408889634f;
  float pmax = p0[0];
#pragma unroll
  for (int r = 1; r < 16; ++r) pmax = fmaxf(pmax, p0[r]);
#pragma unroll
  for (int r = 0; r < 16; ++r) pmax = fmaxf(pmax, p1[r]);
  { auto rr = __builtin_amdgcn_permlane32_swap(__float_as_uint(pmax), __float_as_uint(pmax), false, false);
    pmax = fmaxf(__uint_as_float(rr[0]), __uint_as_float(rr[1])); }
  if (__builtin_expect(__all(pmax - m_reg <= THR / SCALE), 1)) { mn = m_reg; alpha = 1.f; }
  else { mn = fmaxf(m_reg, pmax); alpha = __builtin_amdgcn_exp2f((m_reg - mn) * C); m_reg = mn; }
  float mnC = -mn * C;
#pragma unroll
  for (int r = 0; r < 16; ++r) p0[r] = fmaf(p0[r], C, mnC);
#pragma unroll
  for (int r = 0; r < 16; ++r) p1[r] = fmaf(p1[r], C, mnC);
#pragma unroll
  for (int r = 0; r < 16; ++r) p0[r] = __builtin_amdgcn_exp2f(p0[r]);
}
__device__ __forceinline__ void finishSM(f32x16& p0, f32x16& p1, float alpha, float& l_reg, bf16x8& pa0, bf16x8& pa1, bf16x8& pa2, bf16x8& pa3) {
#pragma unroll
  for (int r = 0; r < 16; ++r) p1[r] = __builtin_amdgcn_exp2f(p1[r]);
  float ps = 0;
#pragma unroll
  for (int r = 0; r < 16; ++r) ps += p0[r];
#pragma unroll
  for (int r = 0; r < 16; ++r) ps += p1[r];
  { auto rr = __builtin_amdgcn_permlane32_swap(__float_as_uint(ps), __float_as_uint(ps), false, false);
    ps = __uint_as_float(rr[0]) + __uint_as_float(rr[1]); }
  l_reg = l_reg * alpha + ps;
#define ATT_PK4(P, BASE, OUT) do { unsigned a0 = cvtpk(P[BASE + 0], P[BASE + 1]), a1 = cvtpk(P[BASE + 2], P[BASE + 3]);   \
    unsigned b0 = cvtpk(P[BASE + 4], P[BASE + 5]), b1 = cvtpk(P[BASE + 6], P[BASE + 7]);                              \
    auto r0 = __builtin_amdgcn_permlane32_swap(a0, b0, false, false); auto r1 = __builtin_amdgcn_permlane32_swap(a1, b1, false, false); \
    u32x4 w = {r0[0], r1[0], r0[1], r1[1]}; OUT = *reinterpret_cast<bf16x8*>(&w); } while (0)
  ATT_PK4(p0, 0, pa0); ATT_PK4(p0, 8, pa1); ATT_PK4(p1, 0, pa2); ATT_PK4(p1, 8, pa3);
#undef ATT_PK4
}
template <int DK> __device__ __forceinline__ void qkt(f32x16& p0, f32x16& p1, const char* Ks, const bf16x8* qr, int r32, int hi) {
  p0 = f32x16{}; p1 = f32x16{};
#pragma unroll
  for (int d0 = 0; d0 < DK / 16; ++d0) { int cb = (d0 * 16 + hi * 8) * 2;
    bf16x8 b0 = *reinterpret_cast<const bf16x8*>(Ks + ATT_KSWZ(r32, cb, DK * 2));
    bf16x8 b1 = *reinterpret_cast<const bf16x8*>(Ks + ATT_KSWZ(32 + r32, cb, DK * 2));
    p0 = __builtin_amdgcn_mfma_f32_32x32x16_bf16(b0, qr[d0], p0, 0, 0, 0);
    p1 = __builtin_amdgcn_mfma_f32_32x32x16_bf16(b1, qr[d0], p1, 0, 0, 0); }
}
__device__ __forceinline__ int v_st(int k, int c) { const int kk = (k & ~0xC) | ((k & 4) << 1) | ((k & 8) >> 1); return ((kk >> 3) * 4 + (c >> 5)) * 512 + ((kk & 7) * 32 + (c & 31)) * 2; }
__device__ __forceinline__ int v_rd_base(int lane) { return ((lane & 3) << 3) | (((lane >> 2) & 3) << 6) | (((lane >> 4) & 1) << 5) | (((lane >> 5) & 1) << 8); }
constexpr int v_rd_off(int d0, int ks, int half) { return d0 * 512 + ks * 4096 + half * 2048; }
template <int OFF> __device__ __forceinline__ s16x4 tr_read(int vb) {
  s16x4 r; asm volatile("ds_read_b64_tr_b16 %0, %1 offset:%2" : "=&v"(r) : "v"(vb), "i"(OFF) : "memory"); return r;
}
template <int D0> __device__ __forceinline__ void pv_one(f32x16& od, int vb, bf16x8 pa0, bf16x8 pa1, bf16x8 pa2, bf16x8 pa3) {
  const s16x4 l0 = tr_read<v_rd_off(D0, 0, 0)>(vb), h0 = tr_read<v_rd_off(D0, 0, 1)>(vb), l1 = tr_read<v_rd_off(D0, 1, 0)>(vb), h1 = tr_read<v_rd_off(D0, 1, 1)>(vb);
  const s16x4 l2 = tr_read<v_rd_off(D0, 2, 0)>(vb), h2 = tr_read<v_rd_off(D0, 2, 1)>(vb), l3 = tr_read<v_rd_off(D0, 3, 0)>(vb), h3 = tr_read<v_rd_off(D0, 3, 1)>(vb);
  asm volatile("s_waitcnt lgkmcnt(0)" ::: "memory"); ATT_SBAR();
#define ATT_PK(L, H) (bf16x8){L[0], L[1], L[2], L[3], H[0], H[1], H[2], H[3]}
  od = __builtin_amdgcn_mfma_f32_32x32x16_bf16(pa0, ATT_PK(l0, h0), od, 0, 0, 0);
  od = __builtin_amdgcn_mfma_f32_32x32x16_bf16(pa1, ATT_PK(l1, h1), od, 0, 0, 0);
  od = __builtin_amdgcn_mfma_f32_32x32x16_bf16(pa2, ATT_PK(l2, h2), od, 0, 0, 0);
  od = __builtin_amdgcn_mfma_f32_32x32x16_bf16(pa3, ATT_PK(l3, h3), od, 0, 0, 0);
#undef ATT_PK
}
__device__ __forceinline__ void pv_d0(f32x16* o, int vb, bf16x8 pa0, bf16x8 pa1, bf16x8 pa2, bf16x8 pa3) {
  pv_one<0>(o[0], vb, pa0, pa1, pa2, pa3); pv_one<1>(o[1], vb, pa0, pa1, pa2, pa3); pv_one<2>(o[2], vb, pa0, pa1, pa2, pa3); pv_one<3>(o[3], vb, pa0, pa1, pa2, pa3);
}

template <int DK, int SDEPTH, int LDQ, int LDKN, int LDV, int LDO>
__device__ __forceinline__ void attn_dense_body(const bf16* __restrict__ Qb, const bf16* __restrict__ Kn, const bf16* __restrict__ Kr, const bf16* __restrict__ Vh,
                                                bf16* __restrict__ Ob, int seq, char* lds, const int wv) {
  constexpr int DKB = DK * 2; constexpr size_t SHM_K = shm_k<DK>();
  const int tid = (wv << 6) | lane_fresh(), wid = wv, lane = tid & 63, r32 = lane & 31, hi = lane >> 5;
  char* V_lds = lds; char* K_lds = lds + 2 * SHM_V;
  float* ws = (float*)(lds + 2 * SHM_V + 2 * SHM_K) + wid * 64; float* li_l = ws; float* al_l = ws + 32;
  float m_reg = -1e30f, l_reg = 0; f32x16 o[4] = {}; bf16x8 qr[DK / 16];
  const bf16* Qw = Qb + (long)(wid * QBLK + r32) * LDQ + hi * 8;
#pragma unroll
  for (int d0 = 0; d0 < DK / 16; ++d0) qr[d0] = ld8(Qw + d0 * 16);
  const int sr = tid >> 4, sc = (tid & 15) * 8, vst0 = v_st(sr, sc), vst1 = v_st(32 + sr, sc);
  const int rr_ = tid >> 3, rc_ = (tid & 7) * 8;
  const int vb0 = (int)(uintptr_t)V_lds + v_rd_base(lane);
  struct { bf16x8 vs0, vs1, ks0, ks1, kr; } sr_[SDEPTH];
#define ATT_SLOAD(i, k0) do { sr_[i].vs0 = ld8(&Vh[(long)((k0) + sr) * LDV + sc]); sr_[i].vs1 = ld8(&Vh[(long)((k0) + 32 + sr) * LDV + sc]); \
    sr_[i].ks0 = ld8(&Kn[(long)((k0) + sr) * LDKN + sc]); sr_[i].ks1 = ld8(&Kn[(long)((k0) + 32 + sr) * LDKN + sc]); \
    if constexpr (DK == 192) sr_[i].kr = ld8(&Kr[(long)((k0) + rr_) * 64 + rc_]); } while (0)
#define ATT_SWRITE(b, i) do { *(bf16x8*)(V_lds + (b) * SHM_V + vst0) = sr_[i].vs0;          \
    *(bf16x8*)(V_lds + (b) * SHM_V + vst1) = sr_[i].vs1; int kc = sc * 2;               \
    *(bf16x8*)(K_lds + (b) * SHM_K + ATT_KSWZ(sr, kc, DKB)) = sr_[i].ks0;                       \
    *(bf16x8*)(K_lds + (b) * SHM_K + ATT_KSWZ(32 + sr, kc, DKB)) = sr_[i].ks1;                   \
    if constexpr (DK == 192) *(bf16x8*)(K_lds + (b) * SHM_K + ATT_KSWZ(rr_, 256 + rc_ * 2, DKB)) = sr_[i].kr; } while (0)
#define ATT_SWAIT() do { if constexpr (SDEPTH == 1) asm volatile("s_waitcnt vmcnt(0)" ::: "memory"); else if constexpr (DK == 192) asm volatile("s_waitcnt vmcnt(5)" ::: "memory"); else asm volatile("s_waitcnt vmcnt(4)" ::: "memory"); } while (0)
#define ATT_RESC(a) do { if (__any((a) < 1.f)) { if (hi == 0) al_l[r32] = (a); asm volatile("s_waitcnt lgkmcnt(0)" ::: "memory"); \
    _Pragma("unroll") for (int d = 0; d < 4; ++d) _Pragma("unroll") for (int r = 0; r < 16; ++r) o[d][r] *= al_l[crow(r, hi)]; } } while (0)
  f32x16 pA0, pA1, pB0, pB1; float mnA, mnB, alA, alB; bf16x8 pa0, pa1, pa2, pa3; const int NT = seq / KVBLK;
  constexpr int SE = 0, SO = SDEPTH - 1;
  ATT_SLOAD(SE, 0); asm volatile("s_waitcnt vmcnt(0)" ::: "memory"); ATT_SWRITE(0, SE); __syncthreads();
  qkt<DK>(pA0, pA1, K_lds, qr, r32, hi); partialSM<DK>(pA0, pA1, m_reg, mnA, alA);
  ATT_SLOAD(SO, KVBLK); if constexpr (SDEPTH == 2) { if (2 < NT) ATT_SLOAD(SE, 2 * KVBLK); }
  ATT_SWAIT(); ATT_SWRITE(1, SO); __syncthreads();
  for (int j = 1; j + 1 < NT; j += 2) {
    ATT_SBAR(); qkt<DK>(pB0, pB1, K_lds + SHM_K, qr, r32, hi);
    finishSM(pA0, pA1, alA, l_reg, pa0, pa1, pa2, pa3); ATT_SBAR();
    ATT_SLOAD(SO, (j + SDEPTH) * KVBLK); ATT_SBAR();
    pv_d0(o, vb0, pa0, pa1, pa2, pa3); partialSM<DK>(pB0, pB1, m_reg, mnB, alB);
    __syncthreads(); ATT_SWAIT(); ATT_SWRITE(0, SE);
    ATT_RESC(alB); __syncthreads();
    ATT_SBAR(); qkt<DK>(pA0, pA1, K_lds, qr, r32, hi);
    finishSM(pB0, pB1, alB, l_reg, pa0, pa1, pa2, pa3); ATT_SBAR();
    if (SDEPTH == 1 || j + 3 < NT) ATT_SLOAD(SE, (j + 1 + SDEPTH) * KVBLK); ATT_SBAR();
    pv_d0(o, vb0 + (int)SHM_V, pa0, pa1, pa2, pa3); partialSM<DK>(pA0, pA1, m_reg, mnA, alA);
    __syncthreads(); ATT_SWAIT(); ATT_SWRITE(1, SO);
    ATT_RESC(alA); __syncthreads();
  }
  ATT_SBAR(); qkt<DK>(pB0, pB1, K_lds + SHM_K, qr, r32, hi);
  finishSM(pA0, pA1, alA, l_reg, pa0, pa1, pa2, pa3); ATT_SBAR();
  pv_d0(o, vb0, pa0, pa1, pa2, pa3); partialSM<DK>(pB0, pB1, m_reg, mnB, alB);
  __syncthreads(); ATT_RESC(alB);
  finishSM(pB0, pB1, alB, l_reg, pa0, pa1, pa2, pa3); ATT_SBAR();
  pv_d0(o, vb0 + (int)SHM_V, pa0, pa1, pa2, pa3);
  if (hi == 0) li_l[r32] = l_reg; asm volatile("s_waitcnt lgkmcnt(0)" ::: "memory");
  float rli[16];
#pragma unroll
  for (int r = 0; r < 16; ++r) rli[r] = __builtin_amdgcn_rcpf(li_l[crow(r, hi)]);
  bf16* Ow = Ob + (long)(wid * QBLK) * LDO;
#pragma unroll
  for (int r = 0; r < 16; ++r) { int orow = crow(r, hi);
#pragma unroll
    for (int d0 = 0; d0 < 4; ++d0) { const float v = o[d0][r] * rli[r]; Ow[(long)orow * LDO + d0 * 32 + r32] = (bf16)(cvtpk(v, v) & 0xffffu); } }
  __syncthreads();
#undef ATT_SLOAD
#undef ATT_SWRITE
#undef ATT_SWAIT
#undef ATT_RESC
}
#undef ATT_KSWZ
#undef ATT_SBAR
}

constexpr int NWAVES = 8;
constexpr int DM = 2048, FF = 4096, NCTX_REQ = 16, CTX_S = 256, NLAT_REQ = 8, LAT_S = 2048, PAST = 512, DEPTH = 4;
constexpr int NCTX = NCTX_REQ * CTX_S;
constexpr int NLAT = NLAT_REQ * LAT_S;
constexpr int MTOK = NCTX + NLAT;
constexpr int KVLAT = PAST + LAT_S;
constexpr int MKV = NCTX + NLAT_REQ * KVLAT;
constexpr int DIN = 2368, DINP = 2560;
constexpr int ZQ = 0, ZKV = 512, ZKR = 768, ZU = 832, ZGQ = 1344, ZGK = 1856, ZGV = 2112;
constexpr int NMOD = 9, MODW = NMOD * DM;
constexpr float EPS = 1e-6f;
constexpr size_t OUT_Y = 0, OUT_CKV = (size_t)MTOK * DM, OUT_KR = OUT_CKV + 16ull * 4 * 256 * 256, OUT_GK = OUT_KR + 16ull * 4 * 256 * 64, OUT_GV = OUT_GK + 16ull * 4 * 256 * 256,
                 OUT_S5 = OUT_GV + 16ull * 4 * 256 * 256, OUT_END = OUT_S5 + 16ull * 4 * 2 * 32 * 64 * 2;
enum { I_XP = 0, I_XS, I_CCKV, I_CKR, I_CGK, I_CGV, I_ST, I_C, I_CCTX, I_WADA, I_BADA, I_NF1, I_G1, I_U1, I_D1, I_NMIX, I_WIN, I_QNORM, I_WUQ, I_KVNORM, I_WUKV,
       I_LRE, I_LIM, I_LDT, I_BRE, I_BIM, I_CRE, I_CIM, I_SD, I_WGLU, I_BGLU, I_GQN, I_GKN, I_WOUT, I_NF2, I_G2, I_U2, I_D2, I_NFIN, N_IN };

constexpr size_t MiB = 1u << 20;
constexpr size_t WS_CTL = 0, CTL_ZERO_BYTES = 1 * MiB;
constexpr size_t WS_MODS = 1 * MiB;
constexpr size_t WS_MODP = 4 * MiB;
constexpr size_t WS_TAB = 26 * MiB;
constexpr size_t WS_S5C = 28 * MiB;
constexpr size_t S5C_BBAR = 256 * 1024, S5C_CMAT = S5C_BBAR + 1 * MiB;
constexpr size_t WS_W = 32 * MiB, W_LAYER = 118 * MiB;
constexpr size_t W_GU1 = 0, W_GU2 = 32 * MiB, W_D1 = 64 * MiB, W_D2 = 80 * MiB, W_IN = 96 * MiB, W_UQ = 106 * MiB, W_UKV = 108 * MiB, W_GLU = 109 * MiB, W_OUT = 110 * MiB;
constexpr size_t WS_X = 512 * MiB, X_BYTES = 160 * MiB;
constexpr size_t WS_H = 1152 * MiB;
constexpr size_t WS_ACT = 1232 * MiB;
constexpr size_t WS_Z = 1392 * MiB;
constexpr size_t WS_QN = 1592 * MiB;
constexpr size_t WS_CKV = 1612 * MiB;
constexpr size_t WS_KR = 1624 * MiB;
constexpr size_t WS_QG = 1628 * MiB;
constexpr size_t WS_KG = 1648 * MiB;
constexpr size_t WS_VG = 1660 * MiB;
constexpr size_t WS_QM = 1672 * MiB;
constexpr size_t WS_KV = 1732 * MiB;
constexpr size_t WS_YP = 1828 * MiB;
constexpr size_t WS_YB = 1868 * MiB;
constexpr size_t WS_MIX = 1888 * MiB;
constexpr size_t WS_DBG = 1968 * MiB;
constexpr size_t WS_END = 1970 * MiB;
constexpr int CW_BAR = 4096;

constexpr int RING_OFF = 0, RING_BYTES = 131072;
constexpr int LDSCTL_OFF = RING_BYTES, MISC_OFF = LDSCTL_OFF + 320;
constexpr int LDS_BYTES = 147456;

#define GAS __attribute__((address_space(1)))
#define LAS __attribute__((address_space(3)))
typedef unsigned short bf16;
typedef unsigned v4u __attribute__((ext_vector_type(4)));
typedef float f32x4 __attribute__((ext_vector_type(4)));
typedef short bf16x8 __attribute__((ext_vector_type(8)));
typedef GAS unsigned gu32;
typedef GAS unsigned long long gu64;
#define RLX_AGENT __ATOMIC_RELAXED, __HIP_MEMORY_SCOPE_AGENT
#define LDS_WAIT() asm volatile("s_waitcnt lgkmcnt(0)" ::: "memory")
#define VM_WAIT() asm volatile("s_waitcnt vmcnt(0)" ::: "memory")
__device__ __forceinline__ unsigned long long rt() { return __builtin_amdgcn_s_memrealtime(); }
__device__ __forceinline__ unsigned f2bf(float f) { unsigned u = __builtin_bit_cast(unsigned, f); return (u + 0x7fffu + ((u >> 16) & 1u)) >> 16; }
__device__ __forceinline__ unsigned pk2(float lo, float hi) { return f2bf(lo) | (f2bf(hi) << 16); }

#define XB_TMO      128
#define XB_XCNT(j)  (256  + 64 * (j))
#define XB_XSUB(j)  (1280 + 64 * (j))
#define XB_XGEN(j)  (2304 + 64 * (j))
#define XB_TOP      3328
#define XB_TOPGEN   3392
#define XCD_BAR_WORDS 3456
#define XB_SPIN_CAP (1u << 18)

__device__ __forceinline__ unsigned xb_ld(unsigned* p)              { return __hip_atomic_load(p, __ATOMIC_RELAXED, __HIP_MEMORY_SCOPE_AGENT); }
__device__ __forceinline__ unsigned xb_add(unsigned* p, unsigned v) { return __hip_atomic_fetch_add(p, v, __ATOMIC_RELAXED, __HIP_MEMORY_SCOPE_AGENT); }
__device__ __forceinline__ unsigned xb_xcc_id() { return (unsigned)__builtin_amdgcn_s_getreg((3 << 11) | 20) & 0xFu; }
#define XB_SPIN(cond, bar) do { unsigned _sp = 0; while (cond) { __builtin_amdgcn_s_sleep(1); \
    if ((++_sp & 255u) == 0u) { if (xb_ld(&(bar)[XB_TMO])) break; if (_sp > XB_SPIN_CAP) { atomicAdd(&(bar)[XB_TMO], 1u); break; } } } } while (0)

struct XcdBarrier {
    unsigned* bar; unsigned x;
    volatile LAS unsigned* st;
    int wv;
};

__device__ __forceinline__ XcdBarrier xcd_barrier_post(unsigned* bar, volatile LAS unsigned* st) {
    XcdBarrier b; b.bar = bar; b.x = xb_xcc_id(); b.st = st; b.wv = 0;
    if (threadIdx.x == 0) (void)xb_add(&bar[XB_XCNT(b.x)], 1u);
    return b;
}
__device__ __forceinline__ void xcd_barrier_complete(unsigned* bar, unsigned x, unsigned& nloc, unsigned& nx) {
    const unsigned G = gridDim.x * gridDim.y * gridDim.z;
    unsigned sum, cnt, mine, sp = 0u;
    for (;;) {
        sum = 0u; cnt = 0u; mine = 0u;
#pragma unroll
        for (unsigned j = 0; j < 16; ++j) { const unsigned c = xb_ld(&bar[XB_XCNT(j)]); sum += c; cnt += (c > 0u) ? 1u : 0u; mine = (j == x) ? c : mine; }
        if (sum == G) break;
        __builtin_amdgcn_s_sleep(1);
        if ((++sp & 255u) == 0u) { if (xb_ld(&bar[XB_TMO])) break; if (sp > XB_SPIN_CAP) { atomicAdd(&bar[XB_TMO], 1u); break; } }
    }
    nloc = mine > 0u ? mine : 1u; nx = cnt > 0u ? cnt : 1u;
}

__device__ __forceinline__ void xcd_barrier(const XcdBarrier& b) {
    asm volatile("s_waitcnt vmcnt(0)" ::: "memory");
    __syncthreads();
    const int xb_t_ = (b.wv << 6) | lane_fresh();
    if (xb_t_ == 0) {
        unsigned* bar = b.bar;
        __builtin_amdgcn_s_waitcnt(0);
        unsigned nloc = b.st[0], nx = b.st[1];
        if (nloc == 0u) { xcd_barrier_complete(bar, b.x, nloc, nx); b.st[0] = nloc; b.st[1] = nx; }
        const unsigned old = xb_add(&bar[XB_XSUB(b.x)], 1u);
        const unsigned gen = old / nloc;
        if (old + 1u == (gen + 1u) * nloc) {
            __builtin_amdgcn_fence(__ATOMIC_RELEASE, "agent");
            asm volatile("s_waitcnt vmcnt(0)" ::: "memory");
            const unsigned og = xb_add(&bar[XB_TOP], 1u);
            const unsigned tg = og / nx;
            if (og + 1u == (tg + 1u) * nx) xb_add(&bar[XB_TOPGEN], 1u);
            else XB_SPIN(xb_ld(&bar[XB_TOPGEN]) == tg, bar);
            __builtin_amdgcn_fence(__ATOMIC_ACQUIRE, "agent");
            xb_add(&bar[XB_XGEN(b.x)], 1u);
            asm volatile("s_waitcnt vmcnt(0)" ::: "memory");
        } else {
            XB_SPIN(xb_ld(&bar[XB_XGEN(b.x)]) == gen, bar);
            __builtin_amdgcn_fence(__ATOMIC_ACQUIRE, "agent");
            asm volatile("s_waitcnt vmcnt(0)" ::: "memory");
        }
    }
    __syncthreads();
}

struct Args { const float* in[N_IN]; float* out; unsigned char* ws; int dbg; int pad; };
struct InTab { __device__ __forceinline__ const float* operator[](int k) const {
    const __attribute__((address_space(4))) char* kp = (const __attribute__((address_space(4))) char*)__builtin_amdgcn_kernarg_segment_ptr(); asm volatile("" : "+s"(kp));
    return *(const float* const __attribute__((address_space(4)))*)(kp + 8 * k); } };
struct Frame {
    LAS unsigned char* lds; char* ldsg;
    volatile LAS unsigned* MISC;
    gu32* ctl;
    int wave;
    int vcu, G;
    InTab in;
    float* out; unsigned char* ws;
};
__device__ __forceinline__ float wave_sum(float v) {
    const int ln = lane_fresh();
#pragma unroll
    for (int o = 1; o < 64; o <<= 1) v += __uint_as_float((unsigned)__builtin_amdgcn_ds_bpermute((ln ^ o) << 2, (int)__float_as_uint(v)));
    return v;
}
__device__ __forceinline__ float grp16_sum(float v) {
    const int ln = lane_fresh();
#pragma unroll
    for (int o = 1; o < 16; o <<= 1) v += __uint_as_float((unsigned)__builtin_amdgcn_ds_bpermute((ln ^ o) << 2, (int)__float_as_uint(v)));
    return v;
}
__device__ __forceinline__ unsigned pkbf(float lo, float hi) { return pg8::cvt_pk_bf16(lo, hi); }
template <class T> __device__ __forceinline__ T* wsp(const Frame& F, size_t off) { return (T*)(F.ws + off); }
__device__ __forceinline__ bf16* wgt(const Frame& F, int l, size_t off) { return (bf16*)(F.ws + WS_W + (size_t)l * W_LAYER + off); }
__device__ __forceinline__ float* xbuf(const Frame& F, int i) { return (float*)(F.ws + WS_X + (size_t)(i & 3) * X_BYTES); }
__device__ __forceinline__ const float* mods(const Frame& F, int l, int chunk) { return (const float*)(F.ws + WS_MODS) + (size_t)l * NMOD * MODW + (size_t)chunk * DM; }

template <int MODE> __device__ __forceinline__ int rowmap(int n) {
    if (MODE == 1) return ((n >> 7) << 8) + (n & 127);
    if (MODE == 2) return ((n >> 7) << 8) + 128 + (n & 127);
    if (MODE == 3) { const int h = n / 192, j = n % 192; if (j < 128) return n; const int jj = j - 128; return h * 192 + 128 + (jj < 32 ? 2 * jj : 2 * (jj - 32) + 1); }
    return n;
}
template <int MODE> __device__ __forceinline__ void p0_transpose_item(const float* W, int K, int N, bf16* WT, LAS float* scr, int item, int lane) {
    const int nblk = N / 32, kb = item / nblk, nb = item % nblk, k0 = 64 * kb, n0 = 32 * nb;
#pragma unroll 8
    for (int i = 0; i < 32; ++i) { const int kk = 2 * i + (lane >> 5); scr[kk * 33 + (lane & 31)] = W[(size_t)(k0 + kk) * N + n0 + (lane & 31)]; }
    LDS_WAIT(); asm volatile("" ::: "memory");
    const int c = lane & 7;
#pragma unroll
    for (int j = 0; j < 4; ++j) { const int n = (lane >> 3) + 8 * j; const LAS float* s = scr + (8 * c) * 33 + n;
        v4u o; o.x = pkbf(s[0 * 33], s[1 * 33]); o.y = pkbf(s[2 * 33], s[3 * 33]); o.z = pkbf(s[4 * 33], s[5 * 33]); o.w = pkbf(s[6 * 33], s[7 * 33]);
        *(GAS v4u*)(WT + (size_t)rowmap<MODE>(n0 + n) * K + k0 + 8 * c) = o; }
    LDS_WAIT(); asm volatile("" ::: "memory");
}
__device__ __forceinline__ void p0_prologue(Frame& F) {
    LAS float* scr = (LAS float*)(F.lds + RING_OFF + F.wave * 16384);
    const int t_ = lane_fresh();
    const int gw = F.vcu * NWAVES + F.wave, NGW = F.G * NWAVES, lane = t_ & 63;
    constexpr int I_GU = (DM / 64) * (FF / 32), I_DN = (FF / 64) * (DM / 32), I_IN = (DM / 64) * (DIN / 32), I_UQ = (512 / 64) * (1536 / 32), I_UKV = (256 / 64) * (2048 / 32),
                  I_GL = (512 / 64) * (512 / 32), I_OUT = (DM / 64) * (DM / 32);
    constexpr int PER_L = 4 * I_GU + 2 * I_DN + I_IN + I_UQ + I_UKV + I_GL + I_OUT;
    for (int it = gw; it < DEPTH * PER_L; it += NGW) {
        const int l = it / PER_L; int r = it % PER_L;
        if (r < I_GU) { p0_transpose_item<1>(F.in[I_G1] + (size_t)l * DM * FF, DM, FF, wgt(F, l, W_GU1), scr, r, lane); continue; } r -= I_GU;
        if (r < I_GU) { p0_transpose_item<2>(F.in[I_U1] + (size_t)l * DM * FF, DM, FF, wgt(F, l, W_GU1), scr, r, lane); continue; } r -= I_GU;
        if (r < I_GU) { p0_transpose_item<1>(F.in[I_G2] + (size_t)l * DM * FF, DM, FF, wgt(F, l, W_GU2), scr, r, lane); continue; } r -= I_GU;
        if (r < I_GU) { p0_transpose_item<2>(F.in[I_U2] + (size_t)l * DM * FF, DM, FF, wgt(F, l, W_GU2), scr, r, lane); continue; } r -= I_GU;
        if (r < I_DN) { p0_transpose_item<0>(F.in[I_D1] + (size_t)l * FF * DM, FF, DM, wgt(F, l, W_D1), scr, r, lane); continue; } r -= I_DN;
        if (r < I_DN) { p0_transpose_item<0>(F.in[I_D2] + (size_t)l * FF * DM, FF, DM, wgt(F, l, W_D2), scr, r, lane); continue; } r -= I_DN;
        if (r < I_IN) { p0_transpose_item<0>(F.in[I_WIN] + (size_t)l * DM * DIN, DM, DIN, wgt(F, l, W_IN), scr, r, lane); continue; } r -= I_IN;
        if (r < I_UQ) { p0_transpose_item<3>(F.in[I_WUQ] + (size_t)l * 512 * 1536, 512, 1536, wgt(F, l, W_UQ), scr, r, lane); continue; } r -= I_UQ;
        if (r < I_UKV) { p0_transpose_item<0>(F.in[I_WUKV] + (size_t)l * 256 * 2048, 256, 2048, wgt(F, l, W_UKV), scr, r, lane); continue; } r -= I_UKV;
        if (r < I_GL) { p0_transpose_item<0>(F.in[I_WGLU] + (size_t)l * 512 * 512, 512, 512, wgt(F, l, W_GLU), scr, r, lane); continue; } r -= I_GL;
        p0_transpose_item<0>(F.in[I_WOUT] + (size_t)l * DM * DM, DM, DM, wgt(F, l, W_OUT), scr, r, lane);
    }
    { const int gt = gw * 64 + lane, NT = NGW * 64; constexpr int PADV = (DINP - DIN) * DM / 8;
      for (int i = gt; i < DEPTH * PADV; i += NT) { const int l = i / PADV, r = i % PADV; *(GAS v4u*)(wgt(F, l, W_IN) + (size_t)DIN * DM + (size_t)r * 8) = (v4u){0u, 0u, 0u, 0u}; } }
    { const int gt = gw * 64 + lane, NT = NGW * 64; float* cosm = wsp<float>(F, WS_TAB); float* sinm = cosm + 2048 * 32; float* cosg = sinm + 2048 * 32; float* sing = cosg + 2048 * 64;
      for (int i = gt; i < 2048 * 32; i += NT) { const int t = i >> 5, j = i & 31; const float pos = (float)(j < 16 ? (t >> 6) : (t & 63)); const int f = j & 15;
          const float inv = powf(10000.0f, -(float)f / 16.0f); const float ang = pos * inv; cosm[i] = cosf(ang); sinm[i] = sinf(ang); }
      for (int i = gt; i < 2048 * 64; i += NT) { const int t = i >> 6, j = i & 63; const float pos = (float)(j < 32 ? (t >> 6) : (t & 63)); const int f = j & 31;
          const float inv = powf(10000.0f, -(float)f / 32.0f); const float ang = pos * inv; cosg[i] = cosf(ang); sing[i] = sinf(ang); } }
    { const int gt = gw * 64 + lane, NT = NGW * 64; float* abar = wsp<float>(F, WS_S5C); bf16* bbar = wsp<bf16>(F, WS_S5C + S5C_BBAR); bf16* cmat = wsp<bf16>(F, WS_S5C + S5C_CMAT);
      for (int i = gt; i < DEPTH * 2 * 32 * 64; i += NT) {
          const int p = i & 63, ldg = i >> 6, g = ldg & 31;
          const float dt = expf(F.in[I_LDT][ldg]); const float lr = F.in[I_LRE][i], li = F.in[I_LIM][i];
          const float mag = expf(lr * dt); const float abr = mag * cosf(li * dt), abi = mag * sinf(li * dt);
          abar[2 * i] = abr; abar[2 * i + 1] = abi;
          const float den = lr * lr + li * li, nr = abr - 1.0f; const float fr = (nr * lr + abi * li) / den, fi = (abi * lr - nr * li) / den;
          const float* br = F.in[I_BRE] + (size_t)i * 16; const float* bi = F.in[I_BIM] + (size_t)i * 16;
          bf16* bo_re = bbar + ((size_t)ldg * 2 * 64 + p) * 16; bf16* bo_im = bo_re + 64 * 16;
#pragma unroll
          for (int c = 0; c < 16; c += 2) { const float r0 = fr * br[c] - fi * bi[c], r1 = fr * br[c + 1] - fi * bi[c + 1], i0 = fr * bi[c] + fi * br[c], i1 = fr * bi[c + 1] + fi * br[c + 1];
              *(unsigned*)(bo_re + c) = pkbf(r0, r1); *(unsigned*)(bo_im + c) = pkbf(i0, i1); }
          const float* cre = F.in[I_CRE] + (size_t)ldg * 16 * 64; const float* cim = F.in[I_CIM] + (size_t)ldg * 16 * 64; (void)g;
#pragma unroll
          for (int c = 0; c < 16; ++c) *(unsigned*)(cmat + ((size_t)ldg * 16 + c) * 128 + 2 * p) = pkbf(cre[c * 64 + p], -cim[c * 64 + p]);
      } }
    { f32x4* part = wsp<f32x4>(F, WS_MODP);
      for (int it = gw; it < DEPTH * 72 * 8; it += NGW) {
          const int ks = it & 7, nc = (it >> 3) % 72, l = it / (72 * 8); const int k0 = ks * 256, n0 = nc * 256;
          for (int idx = lane; idx < 9 * 256; idx += 64) { const int r = idx >> 8, k = idx & 255; const float cv = (r == 0) ? F.in[I_CCTX][k0 + k] : F.in[I_C][(size_t)(r - 1) * DM + k0 + k];
              scr[idx] = cv / (1.0f + expf(-cv)); }
          LDS_WAIT(); asm volatile("" ::: "memory");
          f32x4 acc[9];
#pragma unroll
          for (int r = 0; r < 9; ++r) acc[r] = (f32x4){0.f, 0.f, 0.f, 0.f};
          const float* Wp = F.in[I_WADA] + ((size_t)l * DM + k0) * MODW + n0 + 4 * lane;
          for (int k = 0; k < 256; k += 4) {
              f32x4 w[4];
#pragma unroll
              for (int kk = 0; kk < 4; ++kk) w[kk] = *(const GAS f32x4*)(Wp + (size_t)(k + kk) * MODW);
#pragma unroll
              for (int r = 0; r < 9; ++r) { const f32x4 s = *(const LAS f32x4*)(scr + r * 256 + k);
                  acc[r] += w[0] * s.x; acc[r] += w[1] * s.y; acc[r] += w[2] * s.z; acc[r] += w[3] * s.w; }
          }
#pragma unroll
          for (int r = 0; r < 9; ++r) part[((((size_t)ks * DEPTH + l) * 9 + r) * MODW + n0) / 4 + lane] = acc[r];
          LDS_WAIT(); asm volatile("" ::: "memory");
      } }
}
__device__ __forceinline__ void p0b_mods(Frame& F) {
    const int t_ = lane_fresh();
    const int gt = (F.vcu * NWAVES + F.wave) * 64 + (t_ & 63), NT = F.G * NWAVES * 64;
    const f32x4* part = wsp<f32x4>(F, WS_MODP); f32x4* mo = wsp<f32x4>(F, WS_MODS);
    constexpr int NV = DEPTH * 9 * MODW / 4, LV = MODW / 4;
    for (int i = gt; i < NV; i += NT) { const int n4 = i % LV, l = i / (9 * LV);
        f32x4 s = *((const GAS f32x4*)F.in[I_BADA] + (size_t)l * LV + n4);
#pragma unroll
        for (int ks = 0; ks < 8; ++ks) s += part[(size_t)ks * NV + i];
        mo[i] = s; }
}

__device__ __forceinline__ void modnorm_phase(Frame& F, const float* xa, const float* xb, const float* gain, const float* modl  , bf16* H) {
    const int lane_ = lane_fresh();
    int gw = F.vcu * NWAVES + F.wave; asm volatile("" : "+s"(gw)); const int NGW = F.G * NWAVES, lane = lane_;
    for (int row = gw; row < MTOK; row += NGW) {
        const int req = row < NCTX ? 0 : 1 + ((row - NCTX) >> 11);
        const GAS f32x4* xr = (const GAS f32x4*)((row < NCTX ? xa : xb) + (size_t)row * DM) + lane;
        const GAS f32x4* sh = (const GAS f32x4*)(modl + (size_t)req * MODW) + lane; const GAS f32x4* sc = sh + DM / 4; const GAS f32x4* gn = (const GAS f32x4*)gain + lane;
        f32x4 v[8]; float s = 0.f;
#pragma unroll
        for (int j = 0; j < 8; ++j) { v[j] = xr[64 * j]; s += (v[j].x * v[j].x + v[j].y * v[j].y) + (v[j].z * v[j].z + v[j].w * v[j].w); }
        const float rstd = 1.0f / sqrtf(wave_sum(s) * (1.f / DM) + EPS);
        GAS unsigned long long* o8 = (GAS unsigned long long*)(H + (size_t)row * DM) + lane;
#pragma unroll
        for (int j = 0; j < 8; ++j) { const f32x4 g = gn[64 * j], c = sc[64 * j], b = sh[64 * j];
            const f32x4 y = v[j] * rstd * g * (c + 1.0f) + b;
            o8[64 * j] = (unsigned long long)pkbf(y.x, y.y) | ((unsigned long long)pkbf(y.z, y.w) << 32); }
    }
}
__device__ __forceinline__ void finalnorm_phase(Frame& F, const float* X, const float* gain, float* out) {
    const int t_ = lane_fresh();
    const int gw = F.vcu * NWAVES + F.wave, NGW = F.G * NWAVES, lane = t_ & 63;
    for (int row = gw; row < MTOK; row += NGW) {
        const GAS f32x4* xr = (const GAS f32x4*)(X + (size_t)row * DM) + lane; const GAS f32x4* gn = (const GAS f32x4*)gain + lane;
        f32x4 v[8]; float s = 0.f;
#pragma unroll
        for (int j = 0; j < 8; ++j) { v[j] = xr[64 * j]; s += (v[j].x * v[j].x + v[j].y * v[j].y) + (v[j].z * v[j].z + v[j].w * v[j].w); }
        const float rstd = 1.0f / sqrtf(wave_sum(s) * (1.f / DM) + EPS);
        GAS f32x4* o = (GAS f32x4*)(out + (size_t)row * DM) + lane;
#pragma unroll
        for (int j = 0; j < 8; ++j) o[64 * j] = v[j] * rstd * gn[64 * j];
    }
}

__device__ __forceinline__ void post_row(Frame& F, int l, int row) {
    const int lane_ = lane_fresh(); const int lane = lane_; const bool lat = row >= NCTX;
    const float* zr = wsp<float>(F, WS_Z) + (size_t)row * DINP;
    int kvrow, t = 0, b = 0, s = 0;
    if (lat) { const int r = (row - NCTX) >> 11; t = (row - NCTX) & 2047; kvrow = NCTX + r * KVLAT + PAST + t; } else { kvrow = row; b = row >> 8; s = row & 255; }
    const size_t orow = ((size_t)b * DEPTH + l) * CTX_S + s;
    { const f32x4 a = *(const GAS f32x4*)(zr + ZQ + 8 * lane), c = *(const GAS f32x4*)(zr + ZQ + 8 * lane + 4);
      const float ss = wave_sum((a.x * a.x + a.y * a.y) + (a.z * a.z + a.w * a.w) + (c.x * c.x + c.y * c.y) + (c.z * c.z + c.w * c.w));
      const float rstd = 1.0f / sqrtf(ss * (1.f / 512.f) + EPS);
      const float* gn = F.in[I_QNORM] + (size_t)l * 512 + 8 * lane; const f32x4 g0 = *(const GAS f32x4*)gn, g1 = *(const GAS f32x4*)(gn + 4);
      v4u o; o.x = pkbf(a.x * rstd * g0.x, a.y * rstd * g0.y); o.y = pkbf(a.z * rstd * g0.z, a.w * rstd * g0.w); o.z = pkbf(c.x * rstd * g1.x, c.y * rstd * g1.y); o.w = pkbf(c.z * rstd * g1.z, c.w * rstd * g1.w);
      *(GAS v4u*)(wsp<bf16>(F, WS_QN) + (size_t)row * 512 + 8 * lane) = o; }
    { const f32x4 a = *(const GAS f32x4*)(zr + ZKV + 4 * lane);
      const float ss = wave_sum((a.x * a.x + a.y * a.y) + (a.z * a.z + a.w * a.w)); const float rstd = 1.0f / sqrtf(ss * (1.f / 256.f) + EPS);
      const f32x4 g = *(const GAS f32x4*)(F.in[I_KVNORM] + (size_t)l * 256 + 4 * lane); const f32x4 y = a * rstd * g;
      if (!lat) *(GAS f32x4*)(F.out + OUT_CKV + orow * 256 + 4 * lane) = y;
      *(GAS unsigned long long*)(wsp<bf16>(F, WS_CKV) + (size_t)kvrow * 256 + 4 * lane) = (unsigned long long)pkbf(y.x, y.y) | ((unsigned long long)pkbf(y.z, y.w) << 32); }
    if (lane < 32) { const float x1 = zr[ZKR + lane], x2 = zr[ZKR + 32 + lane]; float y1 = x1, y2 = x2;
      if (lat) { const float c = wsp<float>(F, WS_TAB)[t * 32 + lane], sn = wsp<float>(F, WS_TAB)[2048 * 32 + t * 32 + lane]; y1 = x1 * c - x2 * sn; y2 = x2 * c + x1 * sn; }
      else { F.out[OUT_KR + orow * 64 + lane] = x1; F.out[OUT_KR + orow * 64 + 32 + lane] = x2; }
      *(GAS unsigned*)(wsp<bf16>(F, WS_KR) + (size_t)kvrow * 64 + 2 * lane) = pkbf(y1, y2); }
    { const int hq = lane >> 4, q = lane & 15; const float* zp = zr + ZGQ + hq * 128 + 4 * q;
      const f32x4 a = *(const GAS f32x4*)zp, c = *(const GAS f32x4*)(zp + 64);
      const float ss = grp16_sum((a.x * a.x + a.y * a.y) + (a.z * a.z + a.w * a.w) + (c.x * c.x + c.y * c.y) + (c.z * c.z + c.w * c.w));
      const float rstd = 1.0f / sqrtf(ss * (1.f / 128.f) + EPS);
      const float* gn = F.in[I_GQN] + (size_t)l * 128 + 4 * q; f32x4 y1 = a * rstd * *(const GAS f32x4*)gn, y2 = c * rstd * *(const GAS f32x4*)(gn + 64);
      if (lat) { const float* cg = wsp<float>(F, WS_TAB) + 2 * 2048 * 32 + t * 64 + 4 * q; const f32x4 cs = *(const GAS f32x4*)cg, sn = *(const GAS f32x4*)(cg + 2048 * 64);
          const f32x4 r1 = y1 * cs - y2 * sn, r2 = y2 * cs + y1 * sn; y1 = r1; y2 = r2; }
      bf16* qo = wsp<bf16>(F, WS_QG) + (size_t)row * 512 + hq * 128 + 4 * q;
      *(GAS unsigned long long*)qo = (unsigned long long)pkbf(y1.x, y1.y) | ((unsigned long long)pkbf(y1.z, y1.w) << 32);
      *(GAS unsigned long long*)(qo + 64) = (unsigned long long)pkbf(y2.x, y2.y) | ((unsigned long long)pkbf(y2.z, y2.w) << 32); }
    if (lane < 32) { const int hk = lane >> 4, q = lane & 15; const float* zp = zr + ZGK + hk * 128 + 4 * q;
      const f32x4 a = *(const GAS f32x4*)zp, c = *(const GAS f32x4*)(zp + 64);
      const float ss = grp16_sum((a.x * a.x + a.y * a.y) + (a.z * a.z + a.w * a.w) + (c.x * c.x + c.y * c.y) + (c.z * c.z + c.w * c.w));
      const float rstd = 1.0f / sqrtf(ss * (1.f / 128.f) + EPS);
      const float* gn = F.in[I_GKN] + (size_t)l * 128 + 4 * q; f32x4 y1 = a * rstd * *(const GAS f32x4*)gn, y2 = c * rstd * *(const GAS f32x4*)(gn + 64);
      if (lat) { const float* cg = wsp<float>(F, WS_TAB) + 2 * 2048 * 32 + t * 64 + 4 * q; const f32x4 cs = *(const GAS f32x4*)cg, sn = *(const GAS f32x4*)(cg + 2048 * 64);
          const f32x4 r1 = y1 * cs - y2 * sn, r2 = y2 * cs + y1 * sn; y1 = r1; y2 = r2; }
      else { float* ko = F.out + OUT_GK + orow * 256 + hk * 128 + 4 * q; *(GAS f32x4*)ko = y1; *(GAS f32x4*)(ko + 64) = y2; }
      bf16* kb = wsp<bf16>(F, WS_KG) + (size_t)kvrow * 256 + hk * 128 + 4 * q;
      *(GAS unsigned long long*)kb = (unsigned long long)pkbf(y1.x, y1.y) | ((unsigned long long)pkbf(y1.z, y1.w) << 32);
      *(GAS unsigned long long*)(kb + 64) = (unsigned long long)pkbf(y2.x, y2.y) | ((unsigned long long)pkbf(y2.z, y2.w) << 32);
    } else { const int i = lane - 32; const f32x4 a = *(const GAS f32x4*)(zr + ZGV + 8 * i), c = *(const GAS f32x4*)(zr + ZGV + 8 * i + 4);
      if (!lat) { float* vo = F.out + OUT_GV + orow * 256 + 8 * i; *(GAS f32x4*)vo = a; *(GAS f32x4*)(vo + 4) = c; }
      v4u o; o.x = pkbf(a.x, a.y); o.y = pkbf(a.z, a.w); o.z = pkbf(c.x, c.y); o.w = pkbf(c.z, c.w);
      *(GAS v4u*)(wsp<bf16>(F, WS_VG) + (size_t)kvrow * 256 + 8 * i) = o; }
}
__device__ __forceinline__ void cache_row(Frame& F, int l, int r, int j) {
    const int lane_ = lane_fresh(); const int lane = lane_; const size_t kvrow = (size_t)NCTX + (size_t)r * KVLAT + j; const size_t crow_ = ((size_t)r * DEPTH + l) * PAST + j;
    { const f32x4 a = *(const GAS f32x4*)(F.in[I_CCKV] + crow_ * 256 + 4 * lane);
      *(GAS unsigned long long*)(wsp<bf16>(F, WS_CKV) + kvrow * 256 + 4 * lane) = (unsigned long long)pkbf(a.x, a.y) | ((unsigned long long)pkbf(a.z, a.w) << 32); }
    if (lane < 32) { const float x1 = F.in[I_CKR][crow_ * 64 + lane], x2 = F.in[I_CKR][crow_ * 64 + 32 + lane]; *(GAS unsigned*)(wsp<bf16>(F, WS_KR) + kvrow * 64 + 2 * lane) = pkbf(x1, x2); }
    { const f32x4 a = *(const GAS f32x4*)(F.in[I_CGK] + crow_ * 256 + 4 * lane);
      *(GAS unsigned long long*)(wsp<bf16>(F, WS_KG) + kvrow * 256 + 4 * lane) = (unsigned long long)pkbf(a.x, a.y) | ((unsigned long long)pkbf(a.z, a.w) << 32); }
    { const f32x4 a = *(const GAS f32x4*)(F.in[I_CGV] + crow_ * 256 + 4 * lane);
      *(GAS unsigned long long*)(wsp<bf16>(F, WS_VG) + kvrow * 256 + 4 * lane) = (unsigned long long)pkbf(a.x, a.y) | ((unsigned long long)pkbf(a.z, a.w) << 32); }
}

typedef float f32x16 __attribute__((ext_vector_type(16)));
__device__ __forceinline__ void s5_unit(Frame& F, int l, int b, int g, bool lat, LAS unsigned char* hl) {
    const int lane_ = lane_fresh();
    const int lane = lane_, n = lane & 31, hi = lane >> 5, c16 = lane & 15, q4 = lane >> 4;
    const int S = lat ? LAT_S : CTX_S, NB = S >> 4;
    const int row0 = lat ? NCTX + b * LAT_S : b * CTX_S;
    const float* zb = wsp<float>(F, WS_Z) + (size_t)row0 * DINP + ZU + g * 16;
    float* YP = wsp<float>(F, WS_YP) + (size_t)row0 * 512 + g * 16 + c16;
    bf16* YB = wsp<bf16>(F, WS_YB) + (size_t)row0 * 512 + g * 16 + c16;
    const float* ab = wsp<float>(F, WS_S5C) + ((size_t)((l * 2 + hi) * 32 + g) * 64) * 2;
    const float ar0 = ab[2 * n], ai0 = ab[2 * n + 1], ar1 = ab[2 * (32 + n)], ai1 = ab[2 * (32 + n) + 1];
    bf16x8 Bop[2][2][2];
    bf16x8 Cop[2][4];
#pragma unroll
    for (int d = 0; d < 2; ++d) { const bf16* bb = wsp<bf16>(F, WS_S5C + S5C_BBAR) + (size_t)((l * 2 + d) * 32 + g) * (2 * 64 * 16);
        const bf16* cm = wsp<bf16>(F, WS_S5C + S5C_CMAT) + (size_t)((l * 2 + d) * 32 + g) * (16 * 128);
#pragma unroll
        for (int nb = 0; nb < 2; ++nb)
#pragma unroll
            for (int ri = 0; ri < 2; ++ri) Bop[d][nb][ri] = *(const GAS bf16x8*)(bb + ((size_t)(ri * 64 + 32 * nb + n)) * 16 + 8 * hi);
#pragma unroll
        for (int kb = 0; kb < 4; ++kb) Cop[d][kb] = *(const GAS bf16x8*)(cm + (size_t)c16 * 128 + kb * 32 + 8 * q4); }
    const float dsk = F.in[I_SD][(size_t)l * 512 + g * 16 + c16];
    float hr0 = 0.f, hi0 = 0.f, hr1 = 0.f, hi1 = 0.f;
    if (lat) { const float* st = F.in[I_ST] + ((size_t)(((b * DEPTH + l) * 2 + hi) * 32 + g) * 64) * 2; hr0 = st[2 * n]; hi0 = st[2 * n + 1]; hr1 = st[2 * (32 + n)]; hi1 = st[2 * (32 + n) + 1]; }
    const int rdir = (n >> 2) & 1, rstep = (n & 3) + 4 * (n >> 3);
    const int tA0 = rdir ? (S - 1 - rstep) : rstep; const int tAstep = rdir ? -16 : 16;
    const float* ap = zb + (size_t)tA0 * DINP + 8 * hi; const long astep = (long)tAstep * DINP;
    f32x4 ua0 = *(const GAS f32x4*)ap, ua1 = *(const GAS f32x4*)(ap + 4); ap += astep;
    f32x4 ub0 = *(const GAS f32x4*)ap, ub1 = *(const GAS f32x4*)(ap + 4); ap += astep;
    const f32x16 zero16 = {0.f, 0.f, 0.f, 0.f, 0.f, 0.f, 0.f, 0.f, 0.f, 0.f, 0.f, 0.f, 0.f, 0.f, 0.f, 0.f};
    const bf16x8 zfrag = {0, 0, 0, 0, 0, 0, 0, 0};
    for (int i = 0; i < NB; ++i) {
        f32x4 uc0 = ub0, uc1 = ub1;
        if (i + 2 < NB) { uc0 = *(const GAS f32x4*)ap; uc1 = *(const GAS f32x4*)(ap + 4); ap += astep; }
        const bool fin = (2 * i >= NB);
        float pp[2][4], uu[2][4];
        if (fin) { if (2 * i == NB) asm volatile("s_waitcnt vmcnt(0)" ::: "memory");
#pragma unroll
            for (int d = 0; d < 2; ++d)
#pragma unroll
                for (int j = 0; j < 4; ++j) { const int tt = 16 * i + 4 * q4 + j; const int t = d ? (S - 1 - tt) : tt;
                    pp[d][j] = __uint_as_float(__hip_atomic_load((const unsigned*)(YP + (size_t)t * 512), __ATOMIC_RELAXED, __HIP_MEMORY_SCOPE_AGENT));
                    uu[d][j] = zb[(size_t)t * DINP + c16]; } }
        bf16x8 a; { v4u w; w.x = pkbf(ua0.x, ua0.y); w.y = pkbf(ua0.z, ua0.w); w.z = pkbf(ua1.x, ua1.y); w.w = pkbf(ua1.z, ua1.w); a = __builtin_bit_cast(bf16x8, w); }
        const bf16x8 af = rdir ? zfrag : a, abk = rdir ? a : zfrag;
        f32x16 Dr0 = __builtin_amdgcn_mfma_f32_32x32x16_bf16(af, Bop[0][0][0], zero16, 0, 0, 0); Dr0 = __builtin_amdgcn_mfma_f32_32x32x16_bf16(abk, Bop[1][0][0], Dr0, 0, 0, 0);
        f32x16 Di0 = __builtin_amdgcn_mfma_f32_32x32x16_bf16(af, Bop[0][0][1], zero16, 0, 0, 0); Di0 = __builtin_amdgcn_mfma_f32_32x32x16_bf16(abk, Bop[1][0][1], Di0, 0, 0, 0);
        f32x16 Dr1 = __builtin_amdgcn_mfma_f32_32x32x16_bf16(af, Bop[0][1][0], zero16, 0, 0, 0); Dr1 = __builtin_amdgcn_mfma_f32_32x32x16_bf16(abk, Bop[1][1][0], Dr1, 0, 0, 0);
        f32x16 Di1 = __builtin_amdgcn_mfma_f32_32x32x16_bf16(af, Bop[0][1][1], zero16, 0, 0, 0); Di1 = __builtin_amdgcn_mfma_f32_32x32x16_bf16(abk, Bop[1][1][1], Di1, 0, 0, 0);
        LAS unsigned char* wrow = hl + (hi * 16) * 272 + n * 4;
#pragma unroll
        for (int r = 0; r < 16; ++r) {
            const float nr0 = ar0 * hr0 - ai0 * hi0 + Dr0[r], ni0 = ar0 * hi0 + ai0 * hr0 + Di0[r];
            const float nr1 = ar1 * hr1 - ai1 * hi1 + Dr1[r], ni1 = ar1 * hi1 + ai1 * hr1 + Di1[r];
            hr0 = nr0; hi0 = ni0; hr1 = nr1; hi1 = ni1;
            *(LAS unsigned*)(wrow + r * 272) = pkbf(nr0, ni0); *(LAS unsigned*)(wrow + r * 272 + 128) = pkbf(nr1, ni1);
        }
        asm volatile("s_waitcnt lgkmcnt(0)" ::: "memory");
        f32x4 Y[2];
#pragma unroll
        for (int d = 0; d < 2; ++d) { f32x4 y = {0.f, 0.f, 0.f, 0.f};
#pragma unroll
            for (int kb = 0; kb < 4; ++kb) { const bf16x8 hf = *(const LAS bf16x8*)(hl + (d * 16 + c16) * 272 + (kb * 32 + 8 * q4) * 2);
                y = __builtin_amdgcn_mfma_f32_16x16x32_bf16(hf, Cop[d][kb], y, 0, 0, 0); }
            Y[d] = y; }
#pragma unroll
        for (int d = 0; d < 2; ++d)
#pragma unroll
            for (int j = 0; j < 4; ++j) { const int tt = 16 * i + 4 * q4 + j; const int t = d ? (S - 1 - tt) : tt;
                if (!fin) YP[(size_t)t * 512] = Y[d][j];
                else { const float y = pp[d][j] + Y[d][j] + dsk * uu[d][j]; YB[(size_t)t * 512] = (bf16)(pkbf(y, y) & 0xffffu); } }
        asm volatile("" ::: "memory");
        ua0 = ub0; ua1 = ub1; ub0 = uc0; ub1 = uc1;
    }
    if (!lat) { float* so = F.out + OUT_S5 + ((size_t)(((b * DEPTH + l) * 2 + hi) * 32 + g) * 64) * 2;
        so[2 * n] = hr0; so[2 * n + 1] = hi0; so[2 * (32 + n)] = hr1; so[2 * (32 + n) + 1] = hi1; }
}
__device__ __forceinline__ void post_s5_phase(Frame& F, int l) {
    int w = F.wave, v = F.vcu; asm volatile("" : "+s"(w), "+s"(v));
    LAS unsigned char* hl = F.lds + RING_OFF + w * 16384;
    if (w == 0) { if (v < 256) s5_unit(F, l, v >> 5, v & 31, true, hl); }
    else if (w <= 2) { const int id = v * 2 + (w - 1); if (id < 512) s5_unit(F, l, id >> 5, id & 31, false, hl); }
    else { const int pw = v * 5 + (w - 3), NPW = F.G * 5;
        for (int it = pw; it < MTOK + NLAT_REQ * PAST; it += NPW) { if (it < MTOK) post_row(F, l, it); else { const int k = it - MTOK; cache_row(F, l, k >> 9, k & 511); } } }
}

#ifndef MLA_SDEPTH
#define MLA_SDEPTH 1
#endif
__device__ __forceinline__ void mla_unit(Frame& F, bool lat, int req, int h, int qb) {
    const size_t qrow = lat ? (size_t)NCTX + (size_t)req * LAT_S + (size_t)qb * 256 : (size_t)req * CTX_S;
    const size_t kv0 = lat ? (size_t)NCTX + (size_t)req * KVLAT : (size_t)req * CTX_S; const int seq = lat ? KVLAT : CTX_S;
    const att::bf16* Q = wsp<att::bf16>(F, WS_QM) + qrow * 1536 + h * 192;
    const att::bf16* KVp = wsp<att::bf16>(F, WS_KV) + kv0 * 2048 + h * 256;
    const att::bf16* KRp = wsp<att::bf16>(F, WS_KR) + kv0 * 64;
    att::bf16* O = wsp<att::bf16>(F, WS_MIX) + qrow * 2048 + h * 128;
    att::attn_dense_body<192, MLA_SDEPTH, 1536, 2048, 2048, 2048>(Q, KVp, KRp, KVp + 128, O, seq, F.ldsg + RING_OFF, F.wave);
}
__device__ __forceinline__ void gqa_unit(Frame& F, bool lat, int req, int h, int qb) {
    const size_t qrow = lat ? (size_t)NCTX + (size_t)req * LAT_S + (size_t)qb * 256 : (size_t)req * CTX_S;
    const size_t kv0 = lat ? (size_t)NCTX + (size_t)req * KVLAT : (size_t)req * CTX_S; const int seq = lat ? KVLAT : CTX_S;
    const att::bf16* Q = wsp<att::bf16>(F, WS_QG) + qrow * 512 + h * 128;
    const att::bf16* Kp = wsp<att::bf16>(F, WS_KG) + kv0 * 256 + (h >> 1) * 128;
    const att::bf16* Vp = wsp<att::bf16>(F, WS_VG) + kv0 * 256 + (h >> 1) * 128;
    att::bf16* O = wsp<att::bf16>(F, WS_MIX) + qrow * 2048 + 1536 + h * 128;
    att::attn_dense_body<128, 2, 512, 256, 256, 2048>(Q, Kp, nullptr, Vp, O, seq, F.ldsg + RING_OFF, F.wave);
}
__device__ __forceinline__ void attn_phase(Frame& F) {
    int v = F.vcu; asm volatile("" : "+s"(v));
#ifndef NO_MLA
    for (int k = 0; k < 2; ++k) { const int u = v + 256 * k; mla_unit(F, true, u >> 6, (u >> 3) & 7, u & 7); }
    if (v < 128) mla_unit(F, false, v >> 3, v & 7, 0);
#endif
#ifndef NO_GQA
    { const int u = v; gqa_unit(F, true, u >> 5, (u >> 3) & 3, u & 7); }
    if (v >= 128 && v < 192) { const int u = v - 128; gqa_unit(F, false, u >> 2, u & 3, 0); }
#endif
}

template <class Epi> __device__ __forceinline__ void run_gemm(Frame& F, const bf16* A, const bf16* Bt, int M, int N, int K, const Epi& E) {
    pg8::Gemm g{A, Bt, M, N, K}; pg8::StaticOrder S; S.init(M, N, F.G, (int)blockIdx.x);
    pg8::gemm_phase<Epi, pg8::StaticOrder, true, true>(F.lds + RING_OFF, g, S, E, F.wave);
}
__global__ void __launch_bounds__(NWAVES * 64, 2) fwd_kernel(Args args) {
    extern __shared__ __attribute__((aligned(16))) unsigned char lds[];
    Frame F;
    F.lds = (LAS unsigned char*)lds; F.ldsg = (char*)lds;
    F.MISC = (volatile LAS unsigned*)(F.lds + MISC_OFF);
    F.wave = __builtin_amdgcn_readfirstlane((int)threadIdx.x >> 6);
    F.G = gridDim.x; { const int bx = blockIdx.x; F.vcu = (F.G % 8 == 0) ? (bx % 8) * (F.G / 8) + bx / 8 : bx; }
    F.out = args.out; F.ws = args.ws;
    F.ctl = (gu32*)(args.ws + WS_CTL);
    for (int u = threadIdx.x; u < (LDS_BYTES - LDSCTL_OFF) / 4; u += NWAVES * 64) ((LAS unsigned*)(F.lds + LDSCTL_OFF))[u] = 0u;
    __syncthreads();
    (void)xcd_barrier_post((unsigned*)(F.ctl + CW_BAR), F.MISC + 8);
#define GRID_BAR() do { const __attribute__((address_space(4))) char* kp_ = (const __attribute__((address_space(4))) char*)__builtin_amdgcn_kernarg_segment_ptr(); asm volatile("" : "+s"(kp_)); \
        unsigned char* ws_ = *(unsigned char* const __attribute__((address_space(4)))*)(kp_ + 8 * (N_IN + 1)); \
        XcdBarrier b_; b_.bar = (unsigned*)(ws_ + WS_CTL) + CW_BAR; b_.x = xb_xcc_id(); b_.st = (volatile LAS unsigned*)((LAS unsigned char*)lds + MISC_OFF) + 8; b_.wv = F.wave; xcd_barrier(b_); } while (0)

    bf16* const H = wsp<bf16>(F, WS_H); bf16* const ACT = wsp<bf16>(F, WS_ACT); float* const Z = wsp<float>(F, WS_Z);
    bf16* const MIX = wsp<bf16>(F, WS_MIX);
    const float* cosm = wsp<float>(F, WS_TAB); const float* sinm = cosm + 2048 * 32;

#ifndef NO_PRO
    p0_prologue(F); GRID_BAR();
#endif
    p0b_mods(F); GRID_BAR();

    const float* xa = F.in[I_XP]; const float* xb = F.in[I_XS] - (size_t)NCTX * DM;
    int xi = 0;
    const int nlayers = args.dbg > 0 ? args.dbg : DEPTH;
    for (int l = 0; l < nlayers; ++l) {
        modnorm_phase(F, xa, xb, F.in[I_NF1] + (size_t)l * DM, mods(F, l, 0), H); GRID_BAR();
        { pg8::EpiSwiglu E{ACT, FF}; run_gemm(F, H, wgt(F, l, W_GU1), MTOK, 2 * FF, DM, E); } GRID_BAR();
        { pg8::EpiResid E{xa, xb, xbuf(F, xi), mods(F, l, 2), 0.5f}; run_gemm(F, ACT, wgt(F, l, W_D1), MTOK, DM, FF, E); xa = xb = xbuf(F, xi); ++xi; } GRID_BAR();
        modnorm_phase(F, xa, xb, F.in[I_NMIX] + (size_t)l * DM, mods(F, l, 3), H); GRID_BAR();
        { pg8::EpiF32 E{Z, DINP}; run_gemm(F, H, wgt(F, l, W_IN), MTOK, DINP, DM, E); } GRID_BAR();
#ifndef NO_S5
        post_s5_phase(F, l); GRID_BAR();
#endif
        { pg8::EpiQ E{wsp<bf16>(F, WS_QM), cosm, sinm}; run_gemm(F, wsp<bf16>(F, WS_QN), wgt(F, l, W_UQ), MTOK, 1536, 512, E); }
        { pg8::EpiBf16 E{wsp<bf16>(F, WS_KV), 2048}; run_gemm(F, wsp<bf16>(F, WS_CKV), wgt(F, l, W_UKV), MKV, 2048, 256, E); } GRID_BAR();
#ifndef NO_ATT
        attn_phase(F);
#endif
        { pg8::EpiGlu E{wsp<bf16>(F, WS_YB), F.in[I_BGLU] + (size_t)l * 512, MIX, DM, 1024}; run_gemm(F, wsp<bf16>(F, WS_YB), wgt(F, l, W_GLU), MTOK, 512, 512, E); } GRID_BAR();
        { pg8::EpiResid E{xa, xb, xbuf(F, xi), mods(F, l, 5), 1.0f}; run_gemm(F, MIX, wgt(F, l, W_OUT), MTOK, DM, DM, E); xa = xb = xbuf(F, xi); ++xi; } GRID_BAR();
        modnorm_phase(F, xa, xb, F.in[I_NF2] + (size_t)l * DM, mods(F, l, 6), H); GRID_BAR();
        { pg8::EpiSwiglu E{ACT, FF}; run_gemm(F, H, wgt(F, l, W_GU2), MTOK, 2 * FF, DM, E); } GRID_BAR();
        { pg8::EpiResid E{xa, xb, xbuf(F, xi), mods(F, l, 8), 0.5f}; run_gemm(F, ACT, wgt(F, l, W_D2), MTOK, DM, FF, E); xa = xb = xbuf(F, xi); ++xi; } GRID_BAR();
    }
    finalnorm_phase(F, xa, F.in[I_NFIN], F.out + OUT_Y);
#undef GRID_BAR
}

extern "C" void kernel_launch(void* const* d_in, const int* in_sizes, int n_in, void* d_out, int out_size, void* d_ws, size_t ws_size, hipStream_t stream) {
    static int grid = 0;
    if (grid == 0) {
        if (n_in != N_IN || (size_t)out_size != OUT_END || ws_size < WS_END) { fprintf(stderr, "kernel_launch: shape mismatch: n_in %d out %d ws %zu (need %d, %zu, >= %zu)\n", n_in, out_size, ws_size, (int)N_IN, (size_t)OUT_END, (size_t)WS_END); grid = -1; return; }
        int dev = 0, cus = 0, per_cu = 0;
        if (hipGetDevice(&dev) != hipSuccess || hipDeviceGetAttribute(&cus, hipDeviceAttributeMultiprocessorCount, dev) != hipSuccess) { fprintf(stderr, "kernel_launch: device query failed\n"); grid = -1; return; }
        if (hipFuncSetAttribute((const void*)fwd_kernel, hipFuncAttributeMaxDynamicSharedMemorySize, LDS_BYTES) != hipSuccess) { fprintf(stderr, "kernel_launch: hipFuncSetAttribute failed\n"); grid = -1; return; }
        if (hipOccupancyMaxActiveBlocksPerMultiprocessor(&per_cu, (const void*)fwd_kernel, NWAVES * 64, LDS_BYTES) != hipSuccess || per_cu < 1)
            fprintf(stderr, "kernel_launch: note: occupancy query reports %d workgroups per CU\n", per_cu);
        (void)hipGetLastError();
        grid = cus;
        if (grid != 256) { fprintf(stderr, "kernel_launch: built for 256 CUs, device has %d\n", cus); grid = -1; return; }
    }
    if (grid < 0) return;
    if (hipMemsetAsync((char*)d_ws + WS_CTL, 0, CTL_ZERO_BYTES, stream) != hipSuccess) { fprintf(stderr, "kernel_launch: memset failed\n"); return; }
    Args a{};
    for (int i = 0; i < N_IN; ++i) a.in[i] = (const float*)d_in[i];
    a.out = (float*)d_out; a.ws = (unsigned char*)d_ws; a.dbg = 0; a.pad = 0;
    hipLaunchKernelGGL(fwd_kernel, dim3(grid), dim3(NWAVES * 64), LDS_BYTES, stream, a);
    const hipError_t le = hipPeekAtLastError();
    if (le != hipSuccess) fprintf(stderr, "kernel_launch: launch failed: %s\n", hipGetErrorName(le));
#if DBG_CHECK
    dbg_launch(a, stream);
#endif
}
```

```cpp
#include <hip/hip_runtime.h>
#include <hip/hip_bf16.h>
#include <cstdio>
#include <cstdint>
#include <cmath>
#ifndef DBG_CHECK
#define DBG_CHECK 0
#endif
__device__ __forceinline__ int lane_fresh() { int l; asm volatile("v_mbcnt_lo_u32_b32 %0, -1, 0\n\tv_mbcnt_hi_u32_b32 %0, -1, %0" : "=v"(l)); return l; }
namespace pg8 {
#define PG8_LAS __attribute__((address_space(3)))
typedef unsigned short bf16_t;
typedef short bf16x8 __attribute__((ext_vector_type(8)));
typedef float f32x4 __attribute__((ext_vector_type(4)));
typedef unsigned u32x4 __attribute__((ext_vector_type(4)));
constexpr int BM = 256, BK = 64, HALF = 128, HTB = HALF * BK * 2  , STAGE_BYTES = 8 * HTB, NXCD = 8, WGM = 8;

__host__ __device__ __forceinline__ int lds_byte(int r, int c) { const int st = (r >> 4) * 2 + (c >> 5), rr = r & 15, cc = c & 31, ob = rr * 64 + cc * 2; return st * 1024 + (ob ^ (((ob >> 9) & 1) << 5)); }
__host__ __device__ __forceinline__ void stage_rc(int b, int& R, int& C) { const int st = b / 1024, sb = b % 1024, swz = sb ^ (((sb >> 9) & 1) << 5); R = (st >> 1) * 16 + swz / 64; C = (st & 1) * 32 + (swz % 64) / 2; }
__host__ __device__ __forceinline__ int perm32(int rho) { const int n = rho >> 4, i = rho & 15; return 8 * (i >> 2) + 4 * n + (i & 3); }

struct Unit { int pm, pn; };
struct Gemm { const bf16_t* A; const bf16_t* Bt; int M, N, K; };

struct StaticOrder {
    int nM, nN, nwg, G, c;
    __host__ __device__ void init(int M, int N, int G_, int c_) { nM = M / BM; nN = N / BM; nwg = nM * nN; G = G_; c = c_; }
    __host__ __device__ bool next(int i, Unit& u) const {
        const long L = (long)i * G + c; if (L >= nwg) return false;
        int wgid = (int)L; { const int q = nwg / NXCD, r = nwg % NXCD, xcd = wgid % NXCD, off = wgid / NXCD; wgid = (xcd < r ? xcd * (q + 1) : r * (q + 1) + (xcd - r) * q) + off; }
        const int nig = WGM * nN, gid = wgid / nig, fm = gid * WGM, gsz = (nM - fm) < WGM ? (nM - fm) : WGM;
        u.pm = fm + ((wgid % nig) % gsz); u.pn = (wgid % nig) / gsz; return true;
    }
    __device__ __forceinline__ void a_ready(const Unit&) const {}
    __device__ __forceinline__ void done(const Unit&) const {}
};

__device__ __forceinline__ unsigned cvt_pk_bf16(float lo, float hi) { unsigned r; asm volatile("v_cvt_pk_bf16_f32 %0, %1, %2" : "=v"(r) : "v"(lo), "v"(hi)); return r; }
__device__ __forceinline__ float bf_lo(unsigned w) { return __uint_as_float(w << 16); }
__device__ __forceinline__ float bf_hi(unsigned w) { return __uint_as_float(w & 0xffff0000u); }
__device__ __forceinline__ float fast_sigmoid(float x) { return __builtin_amdgcn_rcpf(1.0f + __builtin_amdgcn_exp2f(-1.4426950408889634f * x)); }
__device__ __forceinline__ int req_of_pm(int pm) { return pm < 16 ? 0 : 1 + ((pm - 16) >> 3); }
constexpr int MODN = 9 * 2048;

struct EpiF32 {
    static constexpr bool PERM = false, AFTER_DRAIN = false;
    float* C; int ldc;
    __device__ __forceinline__ void operator()(const f32x4 (&acc)[2][2][4][2], const Unit& u, int wr, int wc, int fr, int fq) const {
        const int row0 = u.pm * BM + wr * 64 + fr, col0 = u.pn * BM + wc * 32 + 4 * fq;
#pragma unroll
        for (int ai = 0; ai < 2; ++ai)
#pragma unroll
            for (int m = 0; m < 4; ++m) { float* rowp = C + (size_t)(row0 + ai * HALF + m * 16) * ldc + col0;
#pragma unroll
                for (int bj = 0; bj < 2; ++bj)
#pragma unroll
                    for (int n = 0; n < 2; ++n) *(f32x4*)(rowp + bj * HALF + n * 16) = acc[ai][bj][m][n]; }
    }
};
struct EpiBf16 {
    static constexpr bool PERM = true, AFTER_DRAIN = false;
    bf16_t* O; int ldc;
    __device__ __forceinline__ void operator()(const f32x4 (&acc)[2][2][4][2], const Unit& u, int wr, int wc, int fr, int fq) const {
        const int row0 = u.pm * BM + wr * 64 + fr, col0 = u.pn * BM + wc * 32 + 8 * fq;
#pragma unroll
        for (int ai = 0; ai < 2; ++ai)
#pragma unroll
            for (int m = 0; m < 4; ++m) { bf16_t* rowp = O + (size_t)(row0 + ai * HALF + m * 16) * ldc + col0;
#pragma unroll
                for (int bj = 0; bj < 2; ++bj) { const f32x4 v0 = acc[ai][bj][m][0], v1 = acc[ai][bj][m][1];
                    u32x4 w; w.x = cvt_pk_bf16(v0[0], v0[1]); w.y = cvt_pk_bf16(v0[2], v0[3]); w.z = cvt_pk_bf16(v1[0], v1[1]); w.w = cvt_pk_bf16(v1[2], v1[3]);
                    *(u32x4*)(rowp + bj * HALF) = w; } }
    }
};
struct EpiSwiglu {
    static constexpr bool PERM = true, AFTER_DRAIN = false;
    bf16_t* O; int ldc;
    __device__ __forceinline__ void operator()(const f32x4 (&acc)[2][2][4][2], const Unit& u, int wr, int wc, int fr, int fq) const {
        const int row0 = u.pm * BM + wr * 64 + fr, col0 = u.pn * HALF + wc * 32 + 8 * fq;
#pragma unroll
        for (int ai = 0; ai < 2; ++ai)
#pragma unroll
            for (int m = 0; m < 4; ++m) { bf16_t* rowp = O + (size_t)(row0 + ai * HALF + m * 16) * ldc + col0;
                float r[8];
#pragma unroll
                for (int n = 0; n < 2; ++n)
#pragma unroll
                    for (int e = 0; e < 4; ++e) { const float g = acc[ai][0][m][n][e], up = acc[ai][1][m][n][e]; r[4 * n + e] = g * fast_sigmoid(g) * up; }
                u32x4 w; w.x = cvt_pk_bf16(r[0], r[1]); w.y = cvt_pk_bf16(r[2], r[3]); w.z = cvt_pk_bf16(r[4], r[5]); w.w = cvt_pk_bf16(r[6], r[7]);
                *(u32x4*)rowp = w; }
    }
};
struct EpiResid {
    static constexpr bool PERM = false, AFTER_DRAIN = false;
    const float* base_a; const float* base_b; float* out; const float* gate; float coef;
    __device__ __forceinline__ void operator()(const f32x4 (&acc)[2][2][4][2], const Unit& u, int wr, int wc, int fr, int fq) const {
        const int row0 = u.pm * BM + wr * 64 + fr, col0 = u.pn * BM + wc * 32 + 4 * fq;
        const float* g = gate + (size_t)req_of_pm(u.pm) * MODN + col0; const float* base = u.pm < 16 ? base_a : base_b;
        f32x4 gv[2][2];
#pragma unroll
        for (int bj = 0; bj < 2; ++bj)
#pragma unroll
            for (int n = 0; n < 2; ++n) gv[bj][n] = *(const f32x4*)(g + bj * HALF + n * 16) * coef;
#pragma unroll
        for (int ai = 0; ai < 2; ++ai)
#pragma unroll
            for (int m = 0; m < 4; ++m) { const size_t off = (size_t)(row0 + ai * HALF + m * 16) * 2048 + col0;
#pragma unroll
                for (int bj = 0; bj < 2; ++bj)
#pragma unroll
                    for (int n = 0; n < 2; ++n) *(f32x4*)(out + off + bj * HALF + n * 16) = *(const f32x4*)(base + off + bj * HALF + n * 16) + gv[bj][n] * acc[ai][bj][m][n]; }
    }
};
struct EpiQ {
    static constexpr bool PERM = true, AFTER_DRAIN = false;
    bf16_t* O; const float* cosm; const float* sinm;
    __device__ __forceinline__ void operator()(const f32x4 (&acc)[2][2][4][2], const Unit& u, int wr, int wc, int fr, int fq) const {
        const int row0 = u.pm * BM + wr * 64 + fr, col0 = u.pn * BM + wc * 32 + 8 * fq;
#pragma unroll
        for (int ai = 0; ai < 2; ++ai)
#pragma unroll
            for (int m = 0; m < 4; ++m) { const int row = row0 + ai * HALF + m * 16; const int t = (row - 4096) & 2047; bf16_t* rowp = O + (size_t)row * 1536 + col0;
#pragma unroll
                for (int bj = 0; bj < 2; ++bj) { f32x4 v0 = acc[ai][bj][m][0], v1 = acc[ai][bj][m][1];
                    const int cc = (col0 + bj * HALF) % 192;
                    if (cc >= 128 && row >= 4096) { const int j0 = (cc - 128) >> 1;
                        const f32x4 cs = *(const f32x4*)(cosm + t * 32 + j0), sn = *(const f32x4*)(sinm + t * 32 + j0);
                        const f32x4 a = v0, b = v1;
                        v0[0] = a[0] * cs[0] - a[1] * sn[0]; v0[1] = a[1] * cs[0] + a[0] * sn[0];
                        v0[2] = a[2] * cs[1] - a[3] * sn[1]; v0[3] = a[3] * cs[1] + a[2] * sn[1];
                        v1[0] = b[0] * cs[2] - b[1] * sn[2]; v1[1] = b[1] * cs[2] + b[0] * sn[2];
                        v1[2] = b[2] * cs[3] - b[3] * sn[3]; v1[3] = b[3] * cs[3] + b[2] * sn[3]; }
                    u32x4 w; w.x = cvt_pk_bf16(v0[0], v0[1]); w.y = cvt_pk_bf16(v0[2], v0[3]); w.z = cvt_pk_bf16(v1[0], v1[1]); w.w = cvt_pk_bf16(v1[2], v1[3]);
                    *(u32x4*)(rowp + bj * HALF) = w; } }
    }
};
struct EpiGlu {
    static constexpr bool PERM = true, AFTER_DRAIN = false;
    const bf16_t* Y; const float* bias; bf16_t* O; int ldo; int ocol0;
    __device__ __forceinline__ void operator()(const f32x4 (&acc)[2][2][4][2], const Unit& u, int wr, int wc, int fr, int fq) const {
        const int row0 = u.pm * BM + wr * 64 + fr, col0 = u.pn * BM + wc * 32 + 8 * fq;
#pragma unroll
        for (int ai = 0; ai < 2; ++ai)
#pragma unroll
            for (int m = 0; m < 4; ++m) { const int row = row0 + ai * HALF + m * 16;
#pragma unroll
                for (int bj = 0; bj < 2; ++bj) { const int c0 = col0 + bj * HALF;
                    const u32x4 yw = *(const u32x4*)(Y + (size_t)row * 512 + c0);
                    const f32x4 b0 = *(const f32x4*)(bias + c0), b1 = *(const f32x4*)(bias + c0 + 4);
                    const float yv[8] = {bf_lo(yw.x), bf_hi(yw.x), bf_lo(yw.y), bf_hi(yw.y), bf_lo(yw.z), bf_hi(yw.z), bf_lo(yw.w), bf_hi(yw.w)};
                    float r[8];
#pragma unroll
                    for (int e = 0; e < 8; ++e) { const float s = (e < 4 ? acc[ai][bj][m][0][e & 3] + b0[e & 3] : acc[ai][bj][m][1][e & 3] + b1[e & 3]);
                        const float y = yv[e]; const float a2 = 1.5957691216057308f * (y + 0.044715f * y * y * y);
                        r[e] = y * fast_sigmoid(a2) * fast_sigmoid(s); }
                    u32x4 w; w.x = cvt_pk_bf16(r[0], r[1]); w.y = cvt_pk_bf16(r[2], r[3]); w.z = cvt_pk_bf16(r[4], r[5]); w.w = cvt_pk_bf16(r[6], r[7]);
                    *(u32x4*)(O + (size_t)row * ldo + ocol0 + c0) = w; } }
    }
};


__device__ __forceinline__ float rstd_of(const float* ssq, int row) { return 1.0f / sqrtf(ssq[row] * (1.0f / 2048.0f) + 1e-6f); }
struct EpiSwigluN {
    static constexpr bool PERM = true, AFTER_DRAIN = false;
    bf16_t* O; int ldc; const float* ssq; const float* bias;
    __device__ __forceinline__ void operator()(const f32x4 (&acc)[2][2][4][2], const Unit& u, int wr, int wc, int fr, int fq) const {
        const int row0 = u.pm * BM + wr * 64 + fr, col0 = u.pn * HALF + wc * 32 + 8 * fq;
        const float* bp = bias + (size_t)req_of_pm(u.pm) * 8192 + u.pn * BM + wc * 32 + 8 * fq;
        const f32x4 bg0 = *(const f32x4*)bp, bg1 = *(const f32x4*)(bp + 4), bu0 = *(const f32x4*)(bp + HALF), bu1 = *(const f32x4*)(bp + HALF + 4);
#pragma unroll
        for (int ai = 0; ai < 2; ++ai)
#pragma unroll
            for (int m = 0; m < 4; ++m) { const int row = row0 + ai * HALF + m * 16; bf16_t* rowp = O + (size_t)row * ldc + col0; const float rs = rstd_of(ssq, row);
                float r[8];
#pragma unroll
                for (int e = 0; e < 4; ++e) { const float g = rs * acc[ai][0][m][0][e] + bg0[e], up = rs * acc[ai][1][m][0][e] + bu0[e]; r[e] = g * fast_sigmoid(g) * up; }
#pragma unroll
                for (int e = 0; e < 4; ++e) { const float g = rs * acc[ai][0][m][1][e] + bg1[e], up = rs * acc[ai][1][m][1][e] + bu1[e]; r[4 + e] = g * fast_sigmoid(g) * up; }
                u32x4 w; w.x = cvt_pk_bf16(r[0], r[1]); w.y = cvt_pk_bf16(r[2], r[3]); w.z = cvt_pk_bf16(r[4], r[5]); w.w = cvt_pk_bf16(r[6], r[7]);
                *(u32x4*)rowp = w; }
    }
};
struct EpiF32N {
    static constexpr bool PERM = false, AFTER_DRAIN = false;
    float* C; int ldc; const float* ssq; const float* bias;
    __device__ __forceinline__ void operator()(const f32x4 (&acc)[2][2][4][2], const Unit& u, int wr, int wc, int fr, int fq) const {
        const int row0 = u.pm * BM + wr * 64 + fr, col0 = u.pn * BM + wc * 32 + 4 * fq;
        const float* bp = bias + (size_t)req_of_pm(u.pm) * ldc + col0;
        f32x4 bv[2][2];
#pragma unroll
        for (int bj = 0; bj < 2; ++bj)
#pragma unroll
            for (int n = 0; n < 2; ++n) bv[bj][n] = *(const f32x4*)(bp + bj * HALF + n * 16);
#pragma unroll
        for (int ai = 0; ai < 2; ++ai)
#pragma unroll
            for (int m = 0; m < 4; ++m) { const int row = row0 + ai * HALF + m * 16; float* rowp = C + (size_t)row * ldc + col0; const float rs = rstd_of(ssq, row);
#pragma unroll
                for (int bj = 0; bj < 2; ++bj)
#pragma unroll
                    for (int n = 0; n < 2; ++n) *(f32x4*)(rowp + bj * HALF + n * 16) = acc[ai][bj][m][n] * rs + bv[bj][n]; }
    }
};
template <bool HALFSTEP> struct EpiResidFuse {
    static constexpr bool PERM = true, AFTER_DRAIN = false; static constexpr float coef = HALFSTEP ? 0.5f : 1.0f;
    const float* base_a; const float* base_b; float* out; const float* gate;
    bf16_t* XG; const float* gmn; float* ssq;
    __device__ __forceinline__ void operator()(const f32x4 (&acc)[2][2][4][2], const Unit& u, int wr, int wc, int fr, int fq) const {
        const int row0 = u.pm * BM + wr * 64 + fr, col0 = u.pn * BM + wc * 32 + 8 * fq; const int req = req_of_pm(u.pm);
        const float* g = gate + (size_t)req * MODN + col0; const float* base = u.pm < 16 ? base_a : base_b;
        const bool fuse = XG != nullptr; const float* gm = gmn + (size_t)req * 2048 + col0; const int lane = fq * 16 + fr;
        f32x4 gv[2][2], gmv[2][2];
#pragma unroll
        for (int bj = 0; bj < 2; ++bj)
#pragma unroll
            for (int n = 0; n < 2; ++n) { gv[bj][n] = *(const f32x4*)(g + bj * HALF + 4 * n) * coef; gmv[bj][n] = fuse ? *(const f32x4*)(gm + bj * HALF + 4 * n) : (f32x4){0.f, 0.f, 0.f, 0.f}; }
#pragma unroll
        for (int ai = 0; ai < 2; ++ai)
#pragma unroll
            for (int m = 0; m < 4; ++m) { const int row = row0 + ai * HALF + m * 16; const size_t off = (size_t)row * 2048 + col0; float ss = 0.f;
#pragma unroll
                for (int bj = 0; bj < 2; ++bj) {
                    const f32x4 o0 = *(const f32x4*)(base + off + bj * HALF) + gv[bj][0] * acc[ai][bj][m][0], o1 = *(const f32x4*)(base + off + bj * HALF + 4) + gv[bj][1] * acc[ai][bj][m][1];
                    *(f32x4*)(out + off + bj * HALF) = o0; *(f32x4*)(out + off + bj * HALF + 4) = o1;
                    if (fuse) { ss += ((o0[0] * o0[0] + o0[1] * o0[1]) + (o0[2] * o0[2] + o0[3] * o0[3])) + ((o1[0] * o1[0] + o1[1] * o1[1]) + (o1[2] * o1[2] + o1[3] * o1[3]));
                        const f32x4 x0 = o0 * gmv[bj][0], x1 = o1 * gmv[bj][1];
                        u32x4 w; w.x = cvt_pk_bf16(x0[0], x0[1]); w.y = cvt_pk_bf16(x0[2], x0[3]); w.z = cvt_pk_bf16(x1[0], x1[1]); w.w = cvt_pk_bf16(x1[2], x1[3]);
                        *(u32x4*)(XG + off + bj * HALF) = w; } }
                if (fuse) { ss += __uint_as_float((unsigned)__builtin_amdgcn_ds_bpermute((lane ^ 16) << 2, (int)__float_as_uint(ss)));
                    ss += __uint_as_float((unsigned)__builtin_amdgcn_ds_bpermute((lane ^ 32) << 2, (int)__float_as_uint(ss)));
                    if (fq == 0) __hip_atomic_fetch_add(ssq + row, ss, __ATOMIC_RELAXED, __HIP_MEMORY_SCOPE_AGENT); } }
    }
};
template <class Epi, class Sched, bool ALIGN_EPI = false, bool SP2 = false>
__device__ __forceinline__ void gemm_phase(PG8_LAS unsigned char* lds, const Gemm g, const Sched& S, const Epi& E, const int wv  ) {
    const int tid_ = (wv << 6) | lane_fresh();
    const int tid = tid_, wid = __builtin_amdgcn_readfirstlane(tid >> 6), lane = tid & 63, wr = wid >> 2, wc = wid & 3, fr = lane & 15, fq = lane >> 4;
    const int K = g.K, nt = K / BK;
    unsigned voffA[2], voffB[2];
#pragma unroll
    for (int i = 0; i < 2; ++i) { int R, C; stage_rc(tid * 16 + i * 8192, R, C); const int Rb = Epi::PERM ? ((R & ~31) + perm32(R & 31)) : R;
        voffA[i] = (unsigned)(R * K + C) * 2u; voffB[i] = (unsigned)(Rb * K + C) * 2u; }
    const size_t kstep = (size_t)(BK * 2);
    const size_t hstep = (size_t)HALF * K * 2;
    const size_t tstep = 2 * hstep;
    const unsigned ldsw = (unsigned)wid * 1024u;
    const int aoff = lds_byte(wr * 64 + fr, fq * 8), boff = lds_byte(wc * 32 + fr, fq * 8);
#define PG8_SA(b, h) (((b) * 2 + (h)) * HTB)
#define PG8_SB(b, h) ((4 + (b) * 2 + (h)) * HTB)
#define PG8_STAGE(bufoff, gbase, voff) do { _Pragma("unroll") for (int _i = 0; _i < 2; ++_i) \
        __builtin_amdgcn_global_load_lds((const unsigned*)((const char*)(gbase) + (voff)[_i]), (PG8_LAS unsigned*)(lds + (bufoff) + ldsw + _i * 8192), 16, 0, 0); } while (0)
#define PG8_LDA(dst, b, h) do { _Pragma("unroll") for (int m = 0; m < 4; ++m) _Pragma("unroll") for (int k = 0; k < 2; ++k) dst[m][k] = *(const PG8_LAS bf16x8*)(lds + PG8_SA(b, h) + aoff + m * 2048 + k * 1024); } while (0)
#define PG8_LDB(dst, b, h) do { _Pragma("unroll") for (int n = 0; n < 2; ++n) _Pragma("unroll") for (int k = 0; k < 2; ++k) dst[n][k] = *(const PG8_LAS bf16x8*)(lds + PG8_SB(b, h) + boff + n * 2048 + k * 1024); } while (0)
#define PG8_MMA(ai, bj, At, Bt) do { __builtin_amdgcn_s_setprio(1); _Pragma("unroll") for (int m = 0; m < 4; ++m) _Pragma("unroll") for (int n = 0; n < 2; ++n) _Pragma("unroll") for (int k = 0; k < 2; ++k) \
        acc[ai][bj][m][n] = __builtin_amdgcn_mfma_f32_16x16x32_bf16(Bt[n][k], At[m][k], acc[ai][bj][m][n], 0, 0, 0); __builtin_amdgcn_s_setprio(0); } while (0)
#define PG8_WAIT_V(n) asm volatile("s_waitcnt vmcnt(" #n ")" ::: "memory")
#define PG8_WAIT_L(n) asm volatile("s_waitcnt lgkmcnt(" #n ")" ::: "memory")
#define PG8_BAR __builtin_amdgcn_s_barrier()
#define PG8_SCHED __builtin_amdgcn_sched_barrier(0)
    Unit cur, nxt; int ui = 0;
    if (!S.next(0, cur)) return;
    f32x4 acc[2][2][4][2];
#pragma unroll
    for (int a = 0; a < 2; ++a)
#pragma unroll
        for (int b = 0; b < 2; ++b)
#pragma unroll
            for (int m = 0; m < 4; ++m)
#pragma unroll
                for (int n = 0; n < 2; ++n) acc[a][b][m][n] = (f32x4){0.f, 0.f, 0.f, 0.f};
    bf16x8 At[4][2], B0[2][2], B1[2][2];
    const char* cA = (const char*)g.A + (size_t)cur.pm * tstep; const char* cB = (const char*)g.Bt + (size_t)cur.pn * tstep;
    S.a_ready(cur);
    if constexpr (SP2) {
        PG8_STAGE(PG8_SB(0, 0), cB, voffB); PG8_STAGE(PG8_SB(0, 1), cB + hstep, voffB); PG8_STAGE(PG8_SA(0, 0), cA, voffA); PG8_STAGE(PG8_SA(0, 1), cA + hstep, voffA);
        if (wr == 1) PG8_BAR;
        PG8_WAIT_V(2); PG8_BAR;
        PG8_STAGE(PG8_SB(1, 0), cB + kstep, voffB); PG8_STAGE(PG8_SA(1, 0), cA + kstep, voffA); PG8_STAGE(PG8_SB(1, 1), cB + hstep + kstep, voffB);
        PG8_WAIT_V(6); PG8_BAR;
    } else {
        PG8_STAGE(PG8_SB(0, 0), cB, voffB); PG8_STAGE(PG8_SA(0, 0), cA, voffA); PG8_STAGE(PG8_SB(0, 1), cB + hstep, voffB); PG8_STAGE(PG8_SA(0, 1), cA + hstep, voffA);
        if (wr == 1) PG8_BAR;
        PG8_WAIT_V(4); PG8_BAR;
        PG8_STAGE(PG8_SB(1, 0), cB + kstep, voffB); PG8_STAGE(PG8_SA(1, 0), cA + kstep, voffA); PG8_STAGE(PG8_SB(1, 1), cB + hstep + kstep, voffB);
        PG8_WAIT_V(6); PG8_BAR;
    }
    for (;;) {
        const bool has_next = S.next(ui + 1, nxt);
        const char* nA = has_next ? (const char*)g.A + (size_t)nxt.pm * tstep : cA; const char* nB = has_next ? (const char*)g.Bt + (size_t)nxt.pn * tstep : cB;
        for (int t = 0; t < nt; t += 2) {
            const bool last = (t == nt - 2);
            const char* a1 = cA + (size_t)(t + 1) * kstep;
            const char* a2 = last ? nA : cA + (size_t)(t + 2) * kstep; const char* b2 = last ? nB : cB + (size_t)(t + 2) * kstep;
            const char* a3 = a2 + kstep; const char* b3 = b2 + kstep;
            if (last && has_next) S.a_ready(nxt);
            if constexpr (SP2) {
            PG8_LDB(B0, 0, 0); PG8_LDB(B1, 0, 1); PG8_SCHED; PG8_LDA(At, 0, 0); PG8_STAGE(PG8_SA(1, 1), a1 + hstep, voffA);
            PG8_WAIT_V(8); PG8_WAIT_L(0); PG8_BAR; PG8_MMA(0, 0, At, B0); PG8_MMA(0, 1, At, B1); PG8_BAR; PG8_SCHED;
            PG8_LDA(At, 0, 1); PG8_STAGE(PG8_SB(0, 0), b2, voffB); PG8_STAGE(PG8_SB(0, 1), b2 + hstep, voffB); PG8_STAGE(PG8_SA(0, 0), a2, voffA);
            PG8_WAIT_V(8); PG8_WAIT_L(0); PG8_BAR; PG8_MMA(1, 0, At, B0); PG8_MMA(1, 1, At, B1); PG8_BAR; PG8_SCHED;
            PG8_LDB(B0, 1, 0); PG8_LDB(B1, 1, 1); PG8_SCHED; PG8_LDA(At, 1, 0); PG8_STAGE(PG8_SA(0, 1), a2 + hstep, voffA);
            PG8_WAIT_V(8); PG8_WAIT_L(0); PG8_BAR; PG8_MMA(0, 0, At, B0); PG8_MMA(0, 1, At, B1); PG8_BAR; PG8_SCHED;
            PG8_LDA(At, 1, 1); PG8_STAGE(PG8_SB(1, 0), b3, voffB); PG8_STAGE(PG8_SB(1, 1), b3 + hstep, voffB); PG8_STAGE(PG8_SA(1, 0), a3, voffA);
            PG8_WAIT_V(8); PG8_WAIT_L(0); PG8_BAR; PG8_MMA(1, 0, At, B0); PG8_MMA(1, 1, At, B1); PG8_BAR; PG8_SCHED;
            } else {
            PG8_LDB(B0, 0, 0); PG8_SCHED; PG8_LDA(At, 0, 0); PG8_STAGE(PG8_SA(1, 1), a1 + hstep, voffA);
            PG8_WAIT_L(8); PG8_BAR; PG8_WAIT_L(0); PG8_MMA(0, 0, At, B0); PG8_BAR; PG8_SCHED;
            PG8_LDB(B1, 0, 1); PG8_STAGE(PG8_SB(0, 0), b2, voffB);
            PG8_BAR; PG8_WAIT_L(0); PG8_MMA(0, 1, At, B1); PG8_BAR;
            PG8_LDA(At, 0, 1); PG8_STAGE(PG8_SA(0, 0), a2, voffA);
            PG8_BAR; PG8_WAIT_L(0); PG8_MMA(1, 0, At, B0); PG8_BAR; PG8_SCHED;
            PG8_STAGE(PG8_SB(0, 1), b2 + hstep, voffB);
            PG8_WAIT_V(6); PG8_BAR; PG8_MMA(1, 1, At, B1); PG8_BAR;
            PG8_LDB(B0, 1, 0); PG8_SCHED; PG8_LDA(At, 1, 0); PG8_STAGE(PG8_SA(0, 1), a2 + hstep, voffA);
            PG8_WAIT_L(8); PG8_BAR; PG8_WAIT_L(0); PG8_MMA(0, 0, At, B0); PG8_BAR; PG8_SCHED;
            PG8_LDB(B1, 1, 1); PG8_STAGE(PG8_SB(1, 0), b3, voffB);
            PG8_BAR; PG8_WAIT_L(0); PG8_MMA(0, 1, At, B1); PG8_BAR;
            PG8_LDA(At, 1, 1); PG8_STAGE(PG8_SA(1, 0), a3, voffA);
            PG8_BAR; PG8_WAIT_L(0); PG8_MMA(1, 0, At, B0); PG8_BAR; PG8_SCHED;
            PG8_STAGE(PG8_SB(1, 1), b3 + hstep, voffB);
            PG8_WAIT_V(6); PG8_BAR; PG8_MMA(1, 1, At, B1); PG8_BAR;
            }
        }
        if constexpr (ALIGN_EPI) { if (wr == 0) PG8_BAR; }
        if constexpr (!Epi::AFTER_DRAIN) { const int l2_ = lane_fresh();
            E(acc, cur, wr, wc, l2_ & 15, l2_ >> 4); S.done(cur); }
        if (!has_next) break;
#pragma unroll
        for (int a = 0; a < 2; ++a)
#pragma unroll
            for (int b = 0; b < 2; ++b)
#pragma unroll
                for (int m = 0; m < 4; ++m)
#pragma unroll
                    for (int n = 0; n < 2; ++n) acc[a][b][m][n] = (f32x4){0.f, 0.f, 0.f, 0.f};
        cur = nxt; cA = nA; cB = nB; ++ui;
        if constexpr (ALIGN_EPI) { if (wr == 1) PG8_BAR; }
    }
    PG8_WAIT_V(0);
    if constexpr (!ALIGN_EPI) { if (wr == 0) PG8_BAR; }
    PG8_BAR;
    if constexpr (Epi::AFTER_DRAIN) { E.fused(acc, cur, wr, wc, fr, fq, lds, wid, lane); S.done(cur); }
#undef PG8_SA
#undef PG8_SB
#undef PG8_STAGE
#undef PG8_LDA
#undef PG8_LDB
#undef PG8_MMA
#undef PG8_WAIT_V
#undef PG8_WAIT_L
#undef PG8_BAR
#undef PG8_SCHED
}
}
namespace att {
using bf16x8 = __attribute__((ext_vector_type(8))) short;
using s16x4  = __attribute__((ext_vector_type(4))) short;
using f32x16 = __attribute__((ext_vector_type(16))) float;
using u32x4  = __attribute__((ext_vector_type(4))) unsigned;
typedef unsigned short bf16;
constexpr int DV = 128, NW = 8, QBLK = 32, KVBLK = 64;
constexpr float THR = 8.f;
constexpr size_t SHM_V = KVBLK * DV * 2;
template <int DK> constexpr size_t shm_k() { return (size_t)KVBLK * DK * 2; }
template <int DK> constexpr size_t shm_attn() { return 2 * SHM_V + 2 * shm_k<DK>() + NW * 64 * 4; }
#define ATT_KSWZ(row, colB, DKB) ((row) * (DKB) + ((colB) ^ (((row) & 7) << 4)))
#define ATT_SBAR() __builtin_amdgcn_sched_barrier(0)
__device__ __forceinline__ int crow(int r, int hi) { return (r & 3) + 8 * (r >> 2) + 4 * hi; }
__device__ __forceinline__ unsigned cvtpk(float lo, float hi) { unsigned r; asm volatile("v_cvt_pk_bf16_f32 %0, %1, %2" : "=v"(r) : "v"(lo), "v"(hi)); return r; }
__device__ __forceinline__ bf16x8 ld8(const bf16* p) { return *reinterpret_cast<const bf16x8*>(p); }

template <int DK> __device__ __forceinline__ void partialSM(f32x16& p0, f32x16& p1, float& m_reg, float& mn, float& alpha) {
  constexpr float SCALE = (DK == 192) ? 0.07216878364870322f : 0.08838834764831845f;
  constexpr float C = SCALE * 1.4426950408889634f;
  float pmax = p0[0];
#pragma unroll
  for (int r = 1; r < 16; ++r) pmax = fmaxf(pmax, p0[r]);
#pragma unroll
  for (int r = 0; r < 16; ++r) pmax = fmaxf(pmax, p1[r]);
  { auto rr = __builtin_amdgcn_permlane32_swap(__float_as_uint(pmax), __float_as_uint(pmax), false, false);
    pmax = fmaxf(__uint_as_float(rr[0]), __uint_as_float(rr[1])); }
  if (__builtin_expect(__all(pmax - m_reg <= THR / SCALE), 1)) { mn = m_reg; alpha = 1.f; }
  else { mn = fmaxf(m_reg, pmax); alpha = __builtin_amdgcn_exp2f((m_reg - mn) * C); m_reg = mn; }
  float mnC = -mn * C;
#pragma unroll
  for (int r = 0; r < 16; ++r) p0[r] = fmaf(p0[r], C, mnC);
#pragma unroll
  for (int r = 0; r < 16; ++r) p1[r] = fmaf(p1[r], C, mnC);
#pragma unroll
  for (int r = 0; r < 16; ++r) p0[r] = __builtin_amdgcn_exp2f(p0[r]);
}
__device__ __forceinline__ void finishSM(f32x16& p0, f32x16& p1, float alpha, float& l_reg, bf16x8& pa0, bf16x8& pa1, bf16x8& pa2, bf16x8& pa3) {
#pragma unroll
  for (int r = 0; r < 16; ++r) p1[r] = __builtin_amdgcn_exp2f(p1[r]);
  float ps = 0;
#pragma unroll
  for (int r = 0; r < 16; ++r) ps += p0[r];
#pragma unroll
  for (int r = 0; r < 16; ++r) ps += p1[r];
  { auto rr = __builtin_amdgcn_permlane32_swap(__float_as_uint(ps), __float_as_uint(ps), false, false);
    ps = __uint_as_float(rr[0]) + __uint_as_float(rr[1]); }
  l_reg = l_reg * alpha + ps;
#define ATT_PK4(P, BASE, OUT) do { unsigned a0 = cvtpk(P[BASE + 0], P[BASE + 1]), a1 = cvtpk(P[BASE + 2], P[BASE + 3]);   \
    unsigned b0 = cvtpk(P[BASE + 4], P[BASE + 5]), b1 = cvtpk(P[BASE + 6], P[BASE + 7]);                              \
    auto r0 = __builtin_amdgcn_permlane32_swap(a0, b0, false, false); auto r1 = __builtin_amdgcn_permlane32_swap(a1, b1, false, false); \
    u32x4 w = {r0[0], r1[0], r0[1], r1[1]}; OUT = *reinterpret_cast<bf16x8*>(&w); } while (0)
  ATT_PK4(p0, 0, pa0); ATT_PK4(p0, 8, pa1); ATT_PK4(p1, 0, pa2); ATT_PK4(p1, 8, pa3);
#undef ATT_PK4
}
template <int DK> __device__ __forceinline__ void qkt(f32x16& p0, f32x16& p1, const char* Ks, const bf16x8* qr, int r32, int hi) {
  p0 = f32x16{}; p1 = f32x16{};
#pragma unroll
  for (int d0 = 0; d0 < DK / 16; ++d0) { int cb = (d0 * 16 + hi * 8) * 2;
    bf16x8 b0 = *reinterpret_cast<const bf16x8*>(Ks + ATT_KSWZ(r32, cb, DK * 2));
    bf16x8 b1 = *reinterpret_cast<const bf16x8*>(Ks + ATT_KSWZ(32 + r32, cb, DK * 2));
    p0 = __builtin_amdgcn_mfma_f32_32x32x16_bf16(b0, qr[d0], p0, 0, 0, 0);
    p1 = __builtin_amdgcn_mfma_f32_32x32x16_bf16(b1, qr[d0], p1, 0, 0, 0); }
}
__device__ __forceinline__ int v_st(int k, int c) { const int kk = (k & ~0xC) | ((k & 4) << 1) | ((k & 8) >> 1); return ((kk >> 3) * 4 + (c >> 5)) * 512 + ((kk & 7) * 32 + (c & 31)) * 2; }
__device__ __forceinline__ int v_rd_base(int lane) { return ((lane & 3) << 3) | (((lane >> 2) & 3) << 6) | (((lane >> 4) & 1) << 5) | (((lane >> 5) & 1) << 8); }
constexpr int v_rd_off(int d0, int ks, int half) { return d0 * 512 + ks * 4096 + half * 2048; }
template <int OFF> __device__ __forceinline__ s16x4 tr_read(int vb) {
  s16x4 r; asm volatile("ds_read_b64_tr_b16 %0, %1 offset:%2" : "=&v"(r) : "v"(vb), "i"(OFF) : "memory"); return r;
}
template <int D0> __device__ __forceinline__ void pv_one(f32x16& od, int vb, bf16x8 pa0, bf16x8 pa1, bf16x8 pa2, bf16x8 pa3) {
  const s16x4 l0 = tr_read<v_rd_off(D0, 0, 0)>(vb), h0 = tr_read<v_rd_off(D0, 0, 1)>(vb), l1 = tr_read<v_rd_off(D0, 1, 0)>(vb), h1 = tr_read<v_rd_off(D0, 1, 1)>(vb);
  const s16x4 l2 = tr_read<v_rd_off(D0, 2, 0)>(vb), h2 = tr_read<v_rd_off(D0, 2, 1)>(vb), l3 = tr_read<v_rd_off(D0, 3, 0)>(vb), h3 = tr_read<v_rd_off(D0, 3, 1)>(vb);
  asm volatile("s_waitcnt lgkmcnt(0)" ::: "memory"); ATT_SBAR();
#define ATT_PK(L, H) (bf16x8){L[0], L[1], L[2], L[3], H[0], H[1], H[2], H[3]}
  od = __builtin_amdgcn_mfma_f32_32x32x16_bf16(pa0, ATT_PK(l0, h0), od, 0, 0, 0);
  od = __builtin_amdgcn_mfma_f32_32x32x16_bf16(pa1, ATT_PK(l1, h1), od, 0, 0, 0);
  od = __builtin_amdgcn_mfma_f32_32x32x16_bf16(pa2, ATT_PK(l2, h2), od, 0, 0, 0);
  od = __builtin_amdgcn_mfma_f32_32x32x16_bf16(pa3, ATT_PK(l3, h3), od, 0, 0, 0);
#undef ATT_PK
}
__device__ __forceinline__ void pv_d0(f32x16* o, int vb, bf16x8 pa0, bf16x8 pa1, bf16x8 pa2, bf16x8 pa3) {
  pv_one<0>(o[0], vb, pa0, pa1, pa2, pa3); pv_one<1>(o[1], vb, pa0, pa1, pa2, pa3); pv_one<2>(o[2], vb, pa0, pa1, pa2, pa3); pv_one<3>(o[3], vb, pa0, pa1, pa2, pa3);
}

template <int DK, int SDEPTH, int LDQ, int LDKN, int LDV, int LDO>
__device__ __forceinline__ void attn_dense_body(const bf16* __restrict__ Qb, const bf16* __restrict__ Kn, const bf16* __restrict__ Kr, const bf16* __restrict__ Vh,
                                                bf16* __restrict__ Ob, int seq, char* lds, const int wv) {
  constexpr int DKB = DK * 2; constexpr size_t SHM_K = shm_k<DK>();
  const int tid = (wv << 6) | lane_fresh(), wid = wv, lane = tid & 63, r32 = lane & 31, hi = lane >> 5;
  char* V_lds = lds; char* K_lds = lds + 2 * SHM_V;
  float* ws = (float*)(lds + 2 * SHM_V + 2 * SHM_K) + wid * 64; float* li_l = ws; float* al_l = ws + 32;
  float m_reg = -1e30f, l_reg = 0; f32x16 o[4] = {}; bf16x8 qr[DK / 16];
  const bf16* Qw = Qb + (long)(wid * QBLK + r32) * LDQ + hi * 8;
#pragma unroll
  for (int d0 = 0; d0 < DK / 16; ++d0) qr[d0] = ld8(Qw + d0 * 16);
  const int sr = tid >> 4, sc = (tid & 15) * 8, vst0 = v_st(sr, sc), vst1 = v_st(32 + sr, sc);
  const int rr_ = tid >> 3, rc_ = (tid & 7) * 8;
  const int vb0 = (int)(uintptr_t)V_lds + v_rd_base(lane);
  struct { bf16x8 vs0, vs1, ks0, ks1, kr; } sr_[SDEPTH];
#define ATT_SLOAD(i, k0) do { sr_[i].vs0 = ld8(&Vh[(long)((k0) + sr) * LDV + sc]); sr_[i].vs1 = ld8(&Vh[(long)((k0) + 32 + sr) * LDV + sc]); \
    sr_[i].ks0 = ld8(&Kn[(long)((k0) + sr) * LDKN + sc]); sr_[i].ks1 = ld8(&Kn[(long)((k0) + 32 + sr) * LDKN + sc]); \
    if constexpr (DK == 192) sr_[i].kr = ld8(&Kr[(long)((k0) + rr_) * 64 + rc_]); } while (0)
#define ATT_SWRITE(b, i) do { *(bf16x8*)(V_lds + (b) * SHM_V + vst0) = sr_[i].vs0;          \
    *(bf16x8*)(V_lds + (b) * SHM_V + vst1) = sr_[i].vs1; int kc = sc * 2;               \
    *(bf16x8*)(K_lds + (b) * SHM_K + ATT_KSWZ(sr, kc, DKB)) = sr_[i].ks0;                       \
    *(bf16x8*)(K_lds + (b) * SHM_K + ATT_KSWZ(32 + sr, kc, DKB)) = sr_[i].ks1;                   \
    if constexpr (DK == 192) *(bf16x8*)(K_lds + (b) * SHM_K + ATT_KSWZ(rr_, 256 + rc_ * 2, DKB)) = sr_[i].kr; } while (0)
#define ATT_SWAIT() do { if constexpr (SDEPTH == 1) asm volatile("s_waitcnt vmcnt(0)" ::: "memory"); else if constexpr (DK == 192) asm volatile("s_waitcnt vmcnt(5)" ::: "memory"); else asm volatile("s_waitcnt vmcnt(4)" ::: "memory"); } while (0)
#define ATT_RESC(a) do { if (__any((a) < 1.f)) { if (hi == 0) al_l[r32] = (a); asm volatile("s_waitcnt lgkmcnt(0)" ::: "memory"); \
    _Pragma("unroll") for (int d = 0; d < 4; ++d) _Pragma("unroll") for (int r = 0; r < 16; ++r) o[d][r] *= al_l[crow(r, hi)]; } } while (0)
  f32x16 pA0, pA1, pB0, pB1; float mnA, mnB, alA, alB; bf16x8 pa0, pa1, pa2, pa3; const int NT = seq / KVBLK;
  constexpr int SE = 0, SO = SDEPTH - 1;
  ATT_SLOAD(SE, 0); asm volatile("s_waitcnt vmcnt(0)" ::: "memory"); ATT_SWRITE(0, SE); __syncthreads();
  qkt<DK>(pA0, pA1, K_lds, qr, r32, hi); partialSM<DK>(pA0, pA1, m_reg, mnA, alA);
  ATT_SLOAD(SO, KVBLK); if constexpr (SDEPTH == 2) { if (2 < NT) ATT_SLOAD(SE, 2 * KVBLK); }
  ATT_SWAIT(); ATT_SWRITE(1, SO); __syncthreads();
  for (int j = 1; j + 1 < NT; j += 2) {
    ATT_SBAR(); qkt<DK>(pB0, pB1, K_lds + SHM_K, qr, r32, hi);
    finishSM(pA0, pA1, alA, l_reg, pa0, pa1, pa2, pa3); ATT_SBAR();
    ATT_SLOAD(SO, (j + SDEPTH) * KVBLK); ATT_SBAR();
    pv_d0(o, vb0, pa0, pa1, pa2, pa3); partialSM<DK>(pB0, pB1, m_reg, mnB, alB);
    __syncthreads(); ATT_SWAIT(); ATT_SWRITE(0, SE);
    ATT_RESC(alB); __syncthreads();
    ATT_SBAR(); qkt<DK>(pA0, pA1, K_lds, qr, r32, hi);
    finishSM(pB0, pB1, alB, l_reg, pa0, pa1, pa2, pa3); ATT_SBAR();
    if (SDEPTH == 1 || j + 3 < NT) ATT_SLOAD(SE, (j + 1 + SDEPTH) * KVBLK); ATT_SBAR();
    pv_d0(o, vb0 + (int)SHM_V, pa0, pa1, pa2, pa3); partialSM<DK>(pA0, pA1, m_reg, mnA, alA);
    __syncthreads(); ATT_SWAIT(); ATT_SWRITE(1, SO);
    ATT_RESC(alA); __syncthreads();
  }
  ATT_SBAR(); qkt<DK>(pB0, pB1, K_lds + SHM_K, qr, r32, hi);
  finishSM(pA0, pA1, alA, l_reg, pa0, pa1, pa2, pa3); ATT_SBAR();
  pv_d0(o, vb0, pa0, pa1, pa2, pa3); partialSM<DK>(pB0, pB1, m_reg, mnB, alB);
  __syncthreads(); ATT_RESC(alB);
  finishSM(pB0, pB1, alB, l_reg, pa0, pa1, pa2, pa3); ATT_SBAR();
  pv_d0(o, vb0 + (int)SHM_V, pa0, pa1, pa2, pa3);
  if (hi == 0) li_l[r32] = l_reg; asm volatile("s_waitcnt lgkmcnt(0)" ::: "memory");
  float rli[16];
#pragma unroll
  for (int r = 0; r < 16; ++r) rli[r] = __builtin_amdgcn_rcpf(li_l[crow(r, hi)]);
  bf16* Ow = Ob + (long)(wid * QBLK) * LDO;
#pragma unroll
  for (int r = 0; r < 16; ++r) { int orow = crow(r, hi);
#pragma unroll
    for (int d0 = 0; d0 < 4; ++d0) { const float v = o[d0][r] * rli[r]; Ow[(long)orow * LDO + d0 * 32 + r32] = (bf16)(cvtpk(v, v) & 0xffffu); } }
  __syncthreads();
#undef ATT_SLOAD
#undef ATT_SWRITE
#undef ATT_SWAIT
#undef ATT_RESC
}
#undef ATT_KSWZ
#undef ATT_SBAR
}

constexpr int NWAVES = 8;
constexpr int DM = 2048, FF = 4096, NCTX_REQ = 16, CTX_S = 256, NLAT_REQ = 8, LAT_S = 2048, PAST = 512, DEPTH = 4;
constexpr int NCTX = NCTX_REQ * CTX_S;
constexpr int NLAT = NLAT_REQ * LAT_S;
constexpr int MTOK = NCTX + NLAT;
constexpr int KVLAT = PAST + LAT_S;
constexpr int MKV = NCTX + NLAT_REQ * KVLAT;
constexpr int DIN = 2368, DINP = 2560;
constexpr int ZQ = 0, ZKV = 512, ZKR = 768, ZU = 832, ZGQ = 1344, ZGK = 1856, ZGV = 2112;
constexpr int NMOD = 9, MODW = NMOD * DM;
constexpr float EPS = 1e-6f;
constexpr int S5_CH = 256, S5_NB = S5_CH / 16, S5_NCH = LAT_S / S5_CH;
constexpr size_t OUT_Y = 0, OUT_CKV = (size_t)MTOK * DM, OUT_KR = OUT_CKV + 16ull * 4 * 256 * 256, OUT_GK = OUT_KR + 16ull * 4 * 256 * 64, OUT_GV = OUT_GK + 16ull * 4 * 256 * 256,
                 OUT_S5 = OUT_GV + 16ull * 4 * 256 * 256, OUT_END = OUT_S5 + 16ull * 4 * 2 * 32 * 64 * 2;
enum { I_XP = 0, I_XS, I_CCKV, I_CKR, I_CGK, I_CGV, I_ST, I_C, I_CCTX, I_WADA, I_BADA, I_NF1, I_G1, I_U1, I_D1, I_NMIX, I_WIN, I_QNORM, I_WUQ, I_KVNORM, I_WUKV,
       I_LRE, I_LIM, I_LDT, I_BRE, I_BIM, I_CRE, I_CIM, I_SD, I_WGLU, I_BGLU, I_GQN, I_GKN, I_WOUT, I_NF2, I_G2, I_U2, I_D2, I_NFIN, N_IN };

constexpr size_t MiB = 1u << 20;
constexpr size_t WS_CTL = 0, CTL_ZERO_BYTES = 1 * MiB;
constexpr size_t WS_MODS = 1 * MiB;
constexpr size_t WS_MODP = 4 * MiB;
constexpr size_t WS_TAB = 26 * MiB;
constexpr size_t WS_S5C = 28 * MiB;
constexpr size_t S5C_APOW = 128 * 1024, S5C_BBAR = 256 * 1024, S5C_CMAT = S5C_BBAR + 1 * MiB;
constexpr size_t WS_W = 32 * MiB, W_LAYER = 118 * MiB;
constexpr size_t W_GU1 = 0, W_GU2 = 32 * MiB, W_D1 = 64 * MiB, W_D2 = 80 * MiB, W_IN = 96 * MiB, W_UQ = 106 * MiB, W_UKV = 108 * MiB, W_GLU = 109 * MiB, W_OUT = 110 * MiB;
constexpr size_t WS_X = 512 * MiB, X_BYTES = 160 * MiB;
constexpr size_t WS_H = 1152 * MiB;
constexpr size_t WS_ACT = 1232 * MiB;
constexpr size_t WS_Z = 1392 * MiB;
constexpr size_t WS_QN = 1592 * MiB;
constexpr size_t WS_CKV = 1612 * MiB;
constexpr size_t WS_KR = 1624 * MiB;
constexpr size_t WS_QG = 1628 * MiB;
constexpr size_t WS_KG = 1648 * MiB;
constexpr size_t WS_VG = 1660 * MiB;
constexpr size_t WS_QM = 1672 * MiB;
constexpr size_t WS_KV = 1732 * MiB;
constexpr size_t WS_YP = 1828 * MiB;
constexpr size_t WS_YB = 1868 * MiB;
constexpr size_t WS_MIX = 1888 * MiB;
constexpr size_t WS_SL = 1968 * MiB;
constexpr size_t WS_DBG = 1970 * MiB;
constexpr size_t WS_GM = 1972 * MiB;
constexpr size_t WS_BIAS = 1973 * MiB, BIAS_LAYER = 9 * (8192 + 2560 + 8192), BIAS_WIN = 9 * 8192, BIAS_GU2 = 9 * (8192 + 2560);
constexpr size_t WS_SSQ = 25 * MiB, SSQ_BYTES = 12 * MTOK * 4;
constexpr size_t WS_END = 1978 * MiB;
constexpr int CW_BAR = 4096;

constexpr int RING_OFF = 0, RING_BYTES = 131072;
constexpr int LDSCTL_OFF = RING_BYTES, MISC_OFF = LDSCTL_OFF + 320;
constexpr int LDS_BYTES = 147456;

#define GAS __attribute__((address_space(1)))
#define LAS __attribute__((address_space(3)))
typedef unsigned short bf16;
typedef unsigned v4u __attribute__((ext_vector_type(4)));
typedef float f32x4 __attribute__((ext_vector_type(4)));
typedef short bf16x8 __attribute__((ext_vector_type(8)));
typedef GAS unsigned gu32;
typedef GAS unsigned long long gu64;
#define RLX_AGENT __ATOMIC_RELAXED, __HIP_MEMORY_SCOPE_AGENT
#define LDS_WAIT() asm volatile("s_waitcnt lgkmcnt(0)" ::: "memory")
#define VM_WAIT() asm volatile("s_waitcnt vmcnt(0)" ::: "memory")
__device__ __forceinline__ unsigned long long rt() { return __builtin_amdgcn_s_memrealtime(); }
__device__ __forceinline__ unsigned f2bf(float f) { unsigned u = __builtin_bit_cast(unsigned, f); return (u + 0x7fffu + ((u >> 16) & 1u)) >> 16; }
__device__ __forceinline__ unsigned pk2(float lo, float hi) { return f2bf(lo) | (f2bf(hi) << 16); }

#define XB_TMO      128
#define XB_XCNT(j)  (256  + 64 * (j))
#define XB_XSUB(j)  (1280 + 64 * (j))
#define XB_XGEN(j)  (2304 + 64 * (j))
#define XB_TOP      3328
#define XB_TOPGEN   3392
#define XCD_BAR_WORDS 3456
#define XB_SPIN_CAP (1u << 18)

__device__ __forceinline__ unsigned xb_ld(unsigned* p)              { return __hip_atomic_load(p, __ATOMIC_RELAXED, __HIP_MEMORY_SCOPE_AGENT); }
__device__ __forceinline__ unsigned xb_add(unsigned* p, unsigned v) { return __hip_atomic_fetch_add(p, v, __ATOMIC_RELAXED, __HIP_MEMORY_SCOPE_AGENT); }
__device__ __forceinline__ unsigned xb_xcc_id() { return (unsigned)__builtin_amdgcn_s_getreg((3 << 11) | 20) & 0xFu; }
#define XB_SPIN(cond, bar) do { unsigned _sp = 0; while (cond) { __builtin_amdgcn_s_sleep(1); \
    if ((++_sp & 255u) == 0u) { if (xb_ld(&(bar)[XB_TMO])) break; if (_sp > XB_SPIN_CAP) { atomicAdd(&(bar)[XB_TMO], 1u); break; } } } } while (0)

struct XcdBarrier {
    unsigned* bar; unsigned x;
    volatile LAS unsigned* st;
    int wv;
};

__device__ __forceinline__ XcdBarrier xcd_barrier_post(unsigned* bar, volatile LAS unsigned* st) {
    XcdBarrier b; b.bar = bar; b.x = xb_xcc_id(); b.st = st; b.wv = 0;
    if (threadIdx.x == 0) (void)xb_add(&bar[XB_XCNT(b.x)], 1u);
    return b;
}
__device__ __forceinline__ void xcd_barrier_complete(unsigned* bar, unsigned x, unsigned& nloc, unsigned& nx) {
    const unsigned G = gridDim.x * gridDim.y * gridDim.z;
    unsigned sum, cnt, mine, sp = 0u;
    for (;;) {
        sum = 0u; cnt = 0u; mine = 0u;
#pragma unroll
        for (unsigned j = 0; j < 16; ++j) { const unsigned c = xb_ld(&bar[XB_XCNT(j)]); sum += c; cnt += (c > 0u) ? 1u : 0u; mine = (j == x) ? c : mine; }
        if (sum == G) break;
        __builtin_amdgcn_s_sleep(1);
        if ((++sp & 255u) == 0u) { if (xb_ld(&bar[XB_TMO])) break; if (sp > XB_SPIN_CAP) { atomicAdd(&bar[XB_TMO], 1u); break; } }
    }
    nloc = mine > 0u ? mine : 1u; nx = cnt > 0u ? cnt : 1u;
}

__device__ __forceinline__ void xcd_barrier(const XcdBarrier& b) {
    asm volatile("s_waitcnt vmcnt(0)" ::: "memory");
    __syncthreads();
    const int xb_t_ = (b.wv << 6) | lane_fresh();
    if (xb_t_ == 0) {
        unsigned* bar = b.bar;
        __builtin_amdgcn_s_waitcnt(0);
        unsigned nloc = b.st[0], nx = b.st[1];
        if (nloc == 0u) { xcd_barrier_complete(bar, b.x, nloc, nx); b.st[0] = nloc; b.st[1] = nx; }
        const unsigned old = xb_add(&bar[XB_XSUB(b.x)], 1u);
        const unsigned gen = old / nloc;
        if (old + 1u == (gen + 1u) * nloc) {
            __builtin_amdgcn_fence(__ATOMIC_RELEASE, "agent");
            asm volatile("s_waitcnt vmcnt(0)" ::: "memory");
            const unsigned og = xb_add(&bar[XB_TOP], 1u);
            const unsigned tg = og / nx;
            if (og + 1u == (tg + 1u) * nx) xb_add(&bar[XB_TOPGEN], 1u);
            else XB_SPIN(xb_ld(&bar[XB_TOPGEN]) == tg, bar);
            __builtin_amdgcn_fence(__ATOMIC_ACQUIRE, "agent");
            xb_add(&bar[XB_XGEN(b.x)], 1u);
            asm volatile("s_waitcnt vmcnt(0)" ::: "memory");
        } else {
            XB_SPIN(xb_ld(&bar[XB_XGEN(b.x)]) == gen, bar);
            __builtin_amdgcn_fence(__ATOMIC_ACQUIRE, "agent");
            asm volatile("s_waitcnt vmcnt(0)" ::: "memory");
        }
    }
    __syncthreads();
}

struct Args { const float* in[N_IN]; float* out; unsigned char* ws; int dbg; int pad; };
struct InTab { __device__ __forceinline__ const float* operator[](int k) const {
    const __attribute__((address_space(4))) char* kp = (const __attribute__((address_space(4))) char*)__builtin_amdgcn_kernarg_segment_ptr(); asm volatile("" : "+s"(kp));
    return *(const float* const __attribute__((address_space(4)))*)(kp + 8 * k); } };
struct Frame {
    LAS unsigned char* lds; char* ldsg;
    volatile LAS unsigned* MISC;
    gu32* ctl;
    int wave;
    int vcu, G;
    InTab in;
    float* out; unsigned char* ws;
};
__device__ __forceinline__ float wave_sum(float v) {
    const int ln = lane_fresh();
#pragma unroll
    for (int o = 1; o < 64; o <<= 1) v += __uint_as_float((unsigned)__builtin_amdgcn_ds_bpermute((ln ^ o) << 2, (int)__float_as_uint(v)));
    return v;
}
__device__ __forceinline__ float grp16_sum(float v) {
    const int ln = lane_fresh();
#pragma unroll
    for (int o = 1; o < 16; o <<= 1) v += __uint_as_float((unsigned)__builtin_amdgcn_ds_bpermute((ln ^ o) << 2, (int)__float_as_uint(v)));
    return v;
}
__device__ __forceinline__ unsigned pkbf(float lo, float hi) { return pg8::cvt_pk_bf16(lo, hi); }
template <class T> __device__ __forceinline__ T* wsp(const Frame& F, size_t off) { return (T*)(F.ws + off); }
__device__ __forceinline__ bf16* wgt(const Frame& F, int l, size_t off) { return (bf16*)(F.ws + WS_W + (size_t)l * W_LAYER + off); }
__device__ __forceinline__ float* xbuf(const Frame& F, int i) { return (float*)(F.ws + WS_X + (size_t)(i & 3) * X_BYTES); }
__device__ __forceinline__ const float* mods(const Frame& F, int l, int chunk) { return (const float*)(F.ws + WS_MODS) + (size_t)l * NMOD * MODW + (size_t)chunk * DM; }

template <int MODE> __device__ __forceinline__ int rowmap(int n) {
    if (MODE == 1) return ((n >> 7) << 8) + (n & 127);
    if (MODE == 2) return ((n >> 7) << 8) + 128 + (n & 127);
    if (MODE == 3) { const int h = n / 192, j = n % 192; if (j < 128) return n; const int jj = j - 128; return h * 192 + 128 + (jj < 32 ? 2 * jj : 2 * (jj - 32) + 1); }
    return n;
}
template <int MODE> __device__ __forceinline__ void p0_transpose_item(const float* W, int K, int N, bf16* WT, LAS float* scr, int item, int lane) {
    const int nblk = N / 32, kb = item / nblk, nb = item % nblk, k0 = 64 * kb, n0 = 32 * nb;
#pragma unroll 8
    for (int i = 0; i < 32; ++i) { const int kk = 2 * i + (lane >> 5); scr[kk * 33 + (lane & 31)] = W[(size_t)(k0 + kk) * N + n0 + (lane & 31)]; }
    LDS_WAIT(); asm volatile("" ::: "memory");
    const int c = lane & 7;
#pragma unroll
    for (int j = 0; j < 4; ++j) { const int n = (lane >> 3) + 8 * j; const LAS float* s = scr + (8 * c) * 33 + n;
        v4u o; o.x = pkbf(s[0 * 33], s[1 * 33]); o.y = pkbf(s[2 * 33], s[3 * 33]); o.z = pkbf(s[4 * 33], s[5 * 33]); o.w = pkbf(s[6 * 33], s[7 * 33]);
        *(GAS v4u*)(WT + (size_t)rowmap<MODE>(n0 + n) * K + k0 + 8 * c) = o; }
    LDS_WAIT(); asm volatile("" ::: "memory");
}
__device__ __forceinline__ void p0_prologue(Frame& F) {
    LAS float* scr = (LAS float*)(F.lds + RING_OFF + F.wave * 16384);
    const int t_ = lane_fresh();
    const int gw = F.vcu * NWAVES + F.wave, NGW = F.G * NWAVES, lane = t_ & 63;
    constexpr int I_GU = (DM / 64) * (FF / 32), I_DN = (FF / 64) * (DM / 32), I_IN = (DM / 64) * (DIN / 32), I_UQ = (512 / 64) * (1536 / 32), I_UKV = (256 / 64) * (2048 / 32),
                  I_GL = (512 / 64) * (512 / 32), I_OUT = (DM / 64) * (DM / 32);
    constexpr int PER_L = 4 * I_GU + 2 * I_DN + I_IN + I_UQ + I_UKV + I_GL + I_OUT;
    for (int it = gw; it < DEPTH * PER_L; it += NGW) {
        const int l = it / PER_L; int r = it % PER_L;
        if (r < I_GU) { p0_transpose_item<1>(F.in[I_G1] + (size_t)l * DM * FF, DM, FF, wgt(F, l, W_GU1), scr, r, lane); continue; } r -= I_GU;
        if (r < I_GU) { p0_transpose_item<2>(F.in[I_U1] + (size_t)l * DM * FF, DM, FF, wgt(F, l, W_GU1), scr, r, lane); continue; } r -= I_GU;
        if (r < I_GU) { p0_transpose_item<1>(F.in[I_G2] + (size_t)l * DM * FF, DM, FF, wgt(F, l, W_GU2), scr, r, lane); continue; } r -= I_GU;
        if (r < I_GU) { p0_transpose_item<2>(F.in[I_U2] + (size_t)l * DM * FF, DM, FF, wgt(F, l, W_GU2), scr, r, lane); continue; } r -= I_GU;
        if (r < I_DN) { p0_transpose_item<0>(F.in[I_D1] + (size_t)l * FF * DM, FF, DM, wgt(F, l, W_D1), scr, r, lane); continue; } r -= I_DN;
        if (r < I_DN) { p0_transpose_item<0>(F.in[I_D2] + (size_t)l * FF * DM, FF, DM, wgt(F, l, W_D2), scr, r, lane); continue; } r -= I_DN;
        if (r < I_IN) { p0_transpose_item<0>(F.in[I_WIN] + (size_t)l * DM * DIN, DM, DIN, wgt(F, l, W_IN), scr, r, lane); continue; } r -= I_IN;
        if (r < I_UQ) { p0_transpose_item<3>(F.in[I_WUQ] + (size_t)l * 512 * 1536, 512, 1536, wgt(F, l, W_UQ), scr, r, lane); continue; } r -= I_UQ;
        if (r < I_UKV) { p0_transpose_item<0>(F.in[I_WUKV] + (size_t)l * 256 * 2048, 256, 2048, wgt(F, l, W_UKV), scr, r, lane); continue; } r -= I_UKV;
        if (r < I_GL) { p0_transpose_item<0>(F.in[I_WGLU] + (size_t)l * 512 * 512, 512, 512, wgt(F, l, W_GLU), scr, r, lane); continue; } r -= I_GL;
        p0_transpose_item<0>(F.in[I_WOUT] + (size_t)l * DM * DM, DM, DM, wgt(F, l, W_OUT), scr, r, lane);
    }
    { const int gt = gw * 64 + lane, NT = NGW * 64; constexpr int PADV = (DINP - DIN) * DM / 8;
      for (int i = gt; i < DEPTH * PADV; i += NT) { const int l = i / PADV, r = i % PADV; *(GAS v4u*)(wgt(F, l, W_IN) + (size_t)DIN * DM + (size_t)r * 8) = (v4u){0u, 0u, 0u, 0u}; } }
    { const int gt = gw * 64 + lane, NT = NGW * 64; float* cosm = wsp<float>(F, WS_TAB); float* sinm = cosm + 2048 * 32; float* cosg = sinm + 2048 * 32; float* sing = cosg + 2048 * 64;
      for (int i = gt; i < 2048 * 32; i += NT) { const int t = i >> 5, j = i & 31; const float pos = (float)(j < 16 ? (t >> 6) : (t & 63)); const int f = j & 15;
          const float inv = powf(10000.0f, -(float)f / 16.0f); const float ang = pos * inv; cosm[i] = cosf(ang); sinm[i] = sinf(ang); }
      for (int i = gt; i < 2048 * 64; i += NT) { const int t = i >> 6, j = i & 63; const float pos = (float)(j < 32 ? (t >> 6) : (t & 63)); const int f = j & 31;
          const float inv = powf(10000.0f, -(float)f / 32.0f); const float ang = pos * inv; cosg[i] = cosf(ang); sing[i] = sinf(ang); } }
    { const int gt = gw * 64 + lane, NT = NGW * 64; float* abar = wsp<float>(F, WS_S5C); bf16* bbar = wsp<bf16>(F, WS_S5C + S5C_BBAR); bf16* cmat = wsp<bf16>(F, WS_S5C + S5C_CMAT);
      for (int i = gt; i < DEPTH * 2 * 32 * 64; i += NT) {
          const int p = i & 63, ldg = i >> 6, g = ldg & 31;
          const float dt = expf(F.in[I_LDT][ldg]); const float lr = F.in[I_LRE][i], li = F.in[I_LIM][i];
          const float mag = expf(lr * dt); const float abr = mag * cosf(li * dt), abi = mag * sinf(li * dt);
          abar[2 * i] = abr; abar[2 * i + 1] = abi;
          { const double dtd = exp((double)F.in[I_LDT][ldg]); const double m256 = exp((double)lr * dtd * (double)S5_CH), a256 = (double)li * dtd * (double)S5_CH;
            float* apow = wsp<float>(F, WS_S5C + S5C_APOW); apow[2 * i] = (float)(m256 * cos(a256)); apow[2 * i + 1] = (float)(m256 * sin(a256)); }
          const float den = lr * lr + li * li, nr = abr - 1.0f; const float fr = (nr * lr + abi * li) / den, fi = (abi * lr - nr * li) / den;
          const float* br = F.in[I_BRE] + (size_t)i * 16; const float* bi = F.in[I_BIM] + (size_t)i * 16;
          bf16* bo_re = bbar + ((size_t)ldg * 2 * 64 + p) * 16; bf16* bo_im = bo_re + 64 * 16;
#pragma unroll
          for (int c = 0; c < 16; c += 2) { const float r0 = fr * br[c] - fi * bi[c], r1 = fr * br[c + 1] - fi * bi[c + 1], i0 = fr * bi[c] + fi * br[c], i1 = fr * bi[c + 1] + fi * br[c + 1];
              *(unsigned*)(bo_re + c) = pkbf(r0, r1); *(unsigned*)(bo_im + c) = pkbf(i0, i1); }
          const float* cre = F.in[I_CRE] + (size_t)ldg * 16 * 64; const float* cim = F.in[I_CIM] + (size_t)ldg * 16 * 64; (void)g;
#pragma unroll
          for (int c = 0; c < 16; ++c) *(unsigned*)(cmat + ((size_t)ldg * 16 + c) * 128 + 2 * p) = pkbf(cre[c * 64 + p], -cim[c * 64 + p]);
      } }
    { f32x4* part = wsp<f32x4>(F, WS_MODP);
      for (int it = gw; it < DEPTH * 72 * 8; it += NGW) {
          const int ks = it & 7, nc = (it >> 3) % 72, l = it / (72 * 8); const int k0 = ks * 256, n0 = nc * 256;
          for (int idx = lane; idx < 9 * 256; idx += 64) { const int r = idx >> 8, k = idx & 255; const float cv = (r == 0) ? F.in[I_CCTX][k0 + k] : F.in[I_C][(size_t)(r - 1) * DM + k0 + k];
              scr[idx] = cv / (1.0f + expf(-cv)); }
          LDS_WAIT(); asm volatile("" ::: "memory");
          f32x4 acc[9];
#pragma unroll
          for (int r = 0; r < 9; ++r) acc[r] = (f32x4){0.f, 0.f, 0.f, 0.f};
          const float* Wp = F.in[I_WADA] + ((size_t)l * DM + k0) * MODW + n0 + 4 * lane;
          for (int k = 0; k < 256; k += 4) {
              f32x4 w[4];
#pragma unroll
              for (int kk = 0; kk < 4; ++kk) w[kk] = *(const GAS f32x4*)(Wp + (size_t)(k + kk) * MODW);
#pragma unroll
              for (int r = 0; r < 9; ++r) { const f32x4 s = *(const LAS f32x4*)(scr + r * 256 + k);
                  acc[r] += w[0] * s.x; acc[r] += w[1] * s.y; acc[r] += w[2] * s.z; acc[r] += w[3] * s.w; }
          }
#pragma unroll
          for (int r = 0; r < 9; ++r) part[((((size_t)ks * DEPTH + l) * 9 + r) * MODW + n0) / 4 + lane] = acc[r];
          LDS_WAIT(); asm volatile("" ::: "memory");
      } }
}
__device__ __forceinline__ void p0b_mods(Frame& F) {
    const int t_ = lane_fresh();
    const int gt = (F.vcu * NWAVES + F.wave) * 64 + (t_ & 63), NT = F.G * NWAVES * 64;
    const f32x4* part = wsp<f32x4>(F, WS_MODP); f32x4* mo = wsp<f32x4>(F, WS_MODS);
    constexpr int NV = DEPTH * 9 * MODW / 4, LV = MODW / 4;
    for (int i = gt; i < NV; i += NT) { const int n4 = i % LV, l = i / (9 * LV);
        f32x4 s = *((const GAS f32x4*)F.in[I_BADA] + (size_t)l * LV + n4);
#pragma unroll
        for (int ks = 0; ks < 8; ++ks) s += part[(size_t)ks * NV + i];
        mo[i] = s; }
}

__device__ __forceinline__ void p0c_tables(Frame& F) {
    const int lane = lane_fresh(); const int gw = F.vcu * NWAVES + F.wave, NGW = F.G * NWAVES;
    { const int gt = gw * 64 + lane, NT = NGW * 64; float* gm = wsp<float>(F, WS_GM);
      for (int i = gt; i < DEPTH * 3 * 9 * (DM / 4); i += NT) { const int k4 = i % (DM / 4), req = (i / (DM / 4)) % 9, sub = (i / (9 * DM / 4)) % 3, l = i / (27 * DM / 4);
          const float* gain = (sub == 0 ? F.in[I_NF1] : sub == 1 ? F.in[I_NMIX] : F.in[I_NF2]) + (size_t)l * DM;
          const f32x4 g = *((const GAS f32x4*)gain + k4), sc = *((const GAS f32x4*)(mods(F, l, 3 * sub + 1) + (size_t)req * MODW) + k4);
          *((GAS f32x4*)gm + i) = g * (sc + 1.0f); } }
    constexpr int T_GU = 8192 / 64, T_IN = 2560 / 64, T_L = 2 * T_GU + T_IN;
    const int c16 = lane & 15, q4 = lane >> 4;
    for (int it = gw; it < DEPTH * T_L; it += NGW) {
        const int l = it / T_L; int r = it % T_L; const bf16* W; const float* sh; float* bo; int N;
        if (r < T_GU) { W = wgt(F, l, W_GU1); sh = mods(F, l, 0); bo = wsp<float>(F, WS_BIAS) + (size_t)l * BIAS_LAYER; N = 8192; }
        else if (r < T_GU + T_IN) { r -= T_GU; W = wgt(F, l, W_IN); sh = mods(F, l, 3); bo = wsp<float>(F, WS_BIAS) + (size_t)l * BIAS_LAYER + BIAS_WIN; N = 2560; }
        else { r -= T_GU + T_IN; W = wgt(F, l, W_GU2); sh = mods(F, l, 6); bo = wsp<float>(F, WS_BIAS) + (size_t)l * BIAS_LAYER + BIAS_GU2; N = 8192; }
        const int n0 = r * 64;
        const bf16* wp = W + (size_t)(n0 + c16) * DM + 8 * q4;
        const float* sp = sh + (size_t)(c16 < 9 ? c16 : 0) * MODW + 8 * q4;
        f32x4 d[4];
#pragma unroll
        for (int a = 0; a < 4; ++a) d[a] = (f32x4){0.f, 0.f, 0.f, 0.f};
#pragma unroll 4
        for (int kb = 0; kb < DM / 32; ++kb) {
            const f32x4 s0 = *(const GAS f32x4*)(sp + kb * 32), s1 = *(const GAS f32x4*)(sp + kb * 32 + 4);
            v4u w; w.x = pkbf(s0.x, s0.y); w.y = pkbf(s0.z, s0.w); w.z = pkbf(s1.x, s1.y); w.w = pkbf(s1.z, s1.w); if (c16 >= 9) w = (v4u){0u, 0u, 0u, 0u};
            const bf16x8 bfrag = __builtin_bit_cast(bf16x8, w);
#pragma unroll
            for (int a = 0; a < 4; ++a) { const bf16x8 afrag = *(const GAS bf16x8*)(wp + (size_t)a * 16 * DM + kb * 32);
                d[a] = __builtin_amdgcn_mfma_f32_16x16x32_bf16(afrag, bfrag, d[a], 0, 0, 0); }
        }
        if (c16 < 9) {
#pragma unroll
            for (int a = 0; a < 4; ++a) *(GAS f32x4*)(bo + (size_t)c16 * N + n0 + 16 * a + 4 * q4) = d[a]; }
    }
}

__device__ __forceinline__ void modnorm_phase(Frame& F, const float* xa, const float* xb, const float* gain, const float* modl  , bf16* H) {
    const int lane_ = lane_fresh();
    int gw = F.vcu * NWAVES + F.wave; asm volatile("" : "+s"(gw)); const int NGW = F.G * NWAVES, lane = lane_;
    for (int row = gw; row < MTOK; row += NGW) {
        const int req = row < NCTX ? 0 : 1 + ((row - NCTX) >> 11);
        const GAS f32x4* xr = (const GAS f32x4*)((row < NCTX ? xa : xb) + (size_t)row * DM) + lane;
        const GAS f32x4* sh = (const GAS f32x4*)(modl + (size_t)req * MODW) + lane; const GAS f32x4* sc = sh + DM / 4; const GAS f32x4* gn = (const GAS f32x4*)gain + lane;
        f32x4 v[8]; float s = 0.f;
#pragma unroll
        for (int j = 0; j < 8; ++j) { v[j] = xr[64 * j]; s += (v[j].x * v[j].x + v[j].y * v[j].y) + (v[j].z * v[j].z + v[j].w * v[j].w); }
        const float rstd = 1.0f / sqrtf(wave_sum(s) * (1.f / DM) + EPS);
        GAS unsigned long long* o8 = (GAS unsigned long long*)(H + (size_t)row * DM) + lane;
#pragma unroll
        for (int j = 0; j < 8; ++j) { const f32x4 g = gn[64 * j], c = sc[64 * j], b = sh[64 * j];
            const f32x4 y = v[j] * rstd * g * (c + 1.0f) + b;
            o8[64 * j] = (unsigned long long)pkbf(y.x, y.y) | ((unsigned long long)pkbf(y.z, y.w) << 32); }
    }
}
__device__ __forceinline__ void xg0_phase(Frame& F, const float* xa, const float* xb, const float* gm, bf16* XG, float* ssq) {
    const int lane = lane_fresh();
    int gw = F.vcu * NWAVES + F.wave; asm volatile("" : "+s"(gw)); const int NGW = F.G * NWAVES;
    for (int row = gw; row < MTOK; row += NGW) {
        const int req = row < NCTX ? 0 : 1 + ((row - NCTX) >> 11);
        const GAS f32x4* xr = (const GAS f32x4*)((row < NCTX ? xa : xb) + (size_t)row * DM) + lane;
        const GAS f32x4* gp = (const GAS f32x4*)(gm + (size_t)req * DM) + lane;
        f32x4 v[8]; float s = 0.f;
#pragma unroll
        for (int j = 0; j < 8; ++j) { v[j] = xr[64 * j]; s += (v[j].x * v[j].x + v[j].y * v[j].y) + (v[j].z * v[j].z + v[j].w * v[j].w); }
        s = wave_sum(s); if (lane == 0) ssq[row] = s;
        GAS unsigned long long* o8 = (GAS unsigned long long*)(XG + (size_t)row * DM) + lane;
#pragma unroll
        for (int j = 0; j < 8; ++j) { const f32x4 y = v[j] * gp[64 * j];
            o8[64 * j] = (unsigned long long)pkbf(y.x, y.y) | ((unsigned long long)pkbf(y.z, y.w) << 32); }
    }
}
__device__ __forceinline__ void finalnorm_phase(Frame& F, const float* X, const float* gain, float* out) {
    const int t_ = lane_fresh();
    const int gw = F.vcu * NWAVES + F.wave, NGW = F.G * NWAVES, lane = t_ & 63;
    for (int row = gw; row < MTOK; row += NGW) {
        const GAS f32x4* xr = (const GAS f32x4*)(X + (size_t)row * DM) + lane; const GAS f32x4* gn = (const GAS f32x4*)gain + lane;
        f32x4 v[8]; float s = 0.f;
#pragma unroll
        for (int j = 0; j < 8; ++j) { v[j] = xr[64 * j]; s += (v[j].x * v[j].x + v[j].y * v[j].y) + (v[j].z * v[j].z + v[j].w * v[j].w); }
        const float rstd = 1.0f / sqrtf(wave_sum(s) * (1.f / DM) + EPS);
        GAS f32x4* o = (GAS f32x4*)(out + (size_t)row * DM) + lane;
#pragma unroll
        for (int j = 0; j < 8; ++j) o[64 * j] = v[j] * rstd * gn[64 * j];
    }
}

struct PostZ { f32x4 q0, q1, kv, gq0, gq1, g0, g1; float kr1, kr2; };
__device__ __forceinline__ PostZ post_load(Frame& F, int row, int lane) {
    const float* zr = wsp<float>(F, WS_Z) + (size_t)row * DINP; PostZ z;
    z.q0 = *(const GAS f32x4*)(zr + ZQ + 8 * lane); z.q1 = *(const GAS f32x4*)(zr + ZQ + 8 * lane + 4);
    z.kv = *(const GAS f32x4*)(zr + ZKV + 4 * lane);
    z.kr1 = zr[ZKR + (lane & 31)]; z.kr2 = zr[ZKR + 32 + (lane & 31)];
    { const float* zp = zr + ZGQ + (lane >> 4) * 128 + 4 * (lane & 15); z.gq0 = *(const GAS f32x4*)zp; z.gq1 = *(const GAS f32x4*)(zp + 64); }
    if (lane < 32) { const float* zp = zr + ZGK + (lane >> 4) * 128 + 4 * (lane & 15); z.g0 = *(const GAS f32x4*)zp; z.g1 = *(const GAS f32x4*)(zp + 64); }
    else { const float* zp = zr + ZGV + 8 * (lane - 32); z.g0 = *(const GAS f32x4*)zp; z.g1 = *(const GAS f32x4*)(zp + 4); }
    return z;
}
__device__ __forceinline__ void post_row(Frame& F, int l, int row, const PostZ& z, int lane) {
    const bool lat = row >= NCTX;
    int kvrow, t = 0, b = 0, s = 0;
    if (lat) { const int r = (row - NCTX) >> 11; t = (row - NCTX) & 2047; kvrow = NCTX + r * KVLAT + PAST + t; } else { kvrow = row; b = row >> 8; s = row & 255; }
    const size_t orow = ((size_t)b * DEPTH + l) * CTX_S + s;
    { const f32x4 a = z.q0, c = z.q1;
      const float ss = wave_sum((a.x * a.x + a.y * a.y) + (a.z * a.z + a.w * a.w) + (c.x * c.x + c.y * c.y) + (c.z * c.z + c.w * c.w));
      const float rstd = 1.0f / sqrtf(ss * (1.f / 512.f) + EPS);
      const float* gn = F.in[I_QNORM] + (size_t)l * 512 + 8 * lane; const f32x4 g0 = *(const GAS f32x4*)gn, g1 = *(const GAS f32x4*)(gn + 4);
      v4u o; o.x = pkbf(a.x * rstd * g0.x, a.y * rstd * g0.y); o.y = pkbf(a.z * rstd * g0.z, a.w * rstd * g0.w); o.z = pkbf(c.x * rstd * g1.x, c.y * rstd * g1.y); o.w = pkbf(c.z * rstd * g1.z, c.w * rstd * g1.w);
      *(GAS v4u*)(wsp<bf16>(F, WS_QN) + (size_t)row * 512 + 8 * lane) = o; }
    { const f32x4 a = z.kv;
      const float ss = wave_sum((a.x * a.x + a.y * a.y) + (a.z * a.z + a.w * a.w)); const float rstd = 1.0f / sqrtf(ss * (1.f / 256.f) + EPS);
      const f32x4 g = *(const GAS f32x4*)(F.in[I_KVNORM] + (size_t)l * 256 + 4 * lane); const f32x4 y = a * rstd * g;
      if (!lat) *(GAS f32x4*)(F.out + OUT_CKV + orow * 256 + 4 * lane) = y;
      *(GAS unsigned long long*)(wsp<bf16>(F, WS_CKV) + (size_t)kvrow * 256 + 4 * lane) = (unsigned long long)pkbf(y.x, y.y) | ((unsigned long long)pkbf(y.z, y.w) << 32); }
    if (lane < 32) { const float x1 = z.kr1, x2 = z.kr2; float y1 = x1, y2 = x2;
      if (lat) { const float c = wsp<float>(F, WS_TAB)[t * 32 + lane], sn = wsp<float>(F, WS_TAB)[2048 * 32 + t * 32 + lane]; y1 = x1 * c - x2 * sn; y2 = x2 * c + x1 * sn; }
      else { F.out[OUT_KR + orow * 64 + lane] = x1; F.out[OUT_KR + orow * 64 + 32 + lane] = x2; }
      *(GAS unsigned*)(wsp<bf16>(F, WS_KR) + (size_t)kvrow * 64 + 2 * lane) = pkbf(y1, y2); }
    { const int hq = lane >> 4, q = lane & 15;
      const f32x4 a = z.gq0, c = z.gq1;
      const float ss = grp16_sum((a.x * a.x + a.y * a.y) + (a.z * a.z + a.w * a.w) + (c.x * c.x + c.y * c.y) + (c.z * c.z + c.w * c.w));
      const float rstd = 1.0f / sqrtf(ss * (1.f / 128.f) + EPS);
      const float* gn = F.in[I_GQN] + (size_t)l * 128 + 4 * q; f32x4 y1 = a * rstd * *(const GAS f32x4*)gn, y2 = c * rstd * *(const GAS f32x4*)(gn + 64);
      if (lat) { const float* cg = wsp<float>(F, WS_TAB) + 2 * 2048 * 32 + t * 64 + 4 * q; const f32x4 cs = *(const GAS f32x4*)cg, sn = *(const GAS f32x4*)(cg + 2048 * 64);
          const f32x4 r1 = y1 * cs - y2 * sn, r2 = y2 * cs + y1 * sn; y1 = r1; y2 = r2; }
      bf16* qo = wsp<bf16>(F, WS_QG) + (size_t)row * 512 + hq * 128 + 4 * q;
      *(GAS unsigned long long*)qo = (unsigned long long)pkbf(y1.x, y1.y) | ((unsigned long long)pkbf(y1.z, y1.w) << 32);
      *(GAS unsigned long long*)(qo + 64) = (unsigned long long)pkbf(y2.x, y2.y) | ((unsigned long long)pkbf(y2.z, y2.w) << 32); }
    { const f32x4 a = z.g0, c = z.g1;
      const float ss = grp16_sum((a.x * a.x + a.y * a.y) + (a.z * a.z + a.w * a.w) + (c.x * c.x + c.y * c.y) + (c.z * c.z + c.w * c.w));
      if (lane < 32) { const int hk = lane >> 4, q = lane & 15;
        const float rstd = 1.0f / sqrtf(ss * (1.f / 128.f) + EPS);
        const float* gn = F.in[I_GKN] + (size_t)l * 128 + 4 * q; f32x4 y1 = a * rstd * *(const GAS f32x4*)gn, y2 = c * rstd * *(const GAS f32x4*)(gn + 64);
        if (lat) { const float* cg = wsp<float>(F, WS_TAB) + 2 * 2048 * 32 + t * 64 + 4 * q; const f32x4 cs = *(const GAS f32x4*)cg, sn = *(const GAS f32x4*)(cg + 2048 * 64);
            const f32x4 r1 = y1 * cs - y2 * sn, r2 = y2 * cs + y1 * sn; y1 = r1; y2 = r2; }
        else { float* ko = F.out + OUT_GK + orow * 256 + hk * 128 + 4 * q; *(GAS f32x4*)ko = y1; *(GAS f32x4*)(ko + 64) = y2; }
        bf16* kb = wsp<bf16>(F, WS_KG) + (size_t)kvrow * 256 + hk * 128 + 4 * q;
        *(GAS unsigned long long*)kb = (unsigned long long)pkbf(y1.x, y1.y) | ((unsigned long long)pkbf(y1.z, y1.w) << 32);
        *(GAS unsigned long long*)(kb + 64) = (unsigned long long)pkbf(y2.x, y2.y) | ((unsigned long long)pkbf(y2.z, y2.w) << 32);
      } else { const int i = lane - 32;
        if (!lat) { float* vo = F.out + OUT_GV + orow * 256 + 8 * i; *(GAS f32x4*)vo = a; *(GAS f32x4*)(vo + 4) = c; }
        v4u o; o.x = pkbf(a.x, a.y); o.y = pkbf(a.z, a.w); o.z = pkbf(c.x, c.y); o.w = pkbf(c.z, c.w);
        *(GAS v4u*)(wsp<bf16>(F, WS_VG) + (size_t)kvrow * 256 + 8 * i) = o; } }
}
__device__ __forceinline__ void cache_row(Frame& F, int l, int r, int j) {
    const int lane_ = lane_fresh(); const int lane = lane_; const size_t kvrow = (size_t)NCTX + (size_t)r * KVLAT + j; const size_t crow_ = ((size_t)r * DEPTH + l) * PAST + j;
    { const f32x4 a = *(const GAS f32x4*)(F.in[I_CCKV] + crow_ * 256 + 4 * lane);
      *(GAS unsigned long long*)(wsp<bf16>(F, WS_CKV) + kvrow * 256 + 4 * lane) = (unsigned long long)pkbf(a.x, a.y) | ((unsigned long long)pkbf(a.z, a.w) << 32); }
    if (lane < 32) { const float x1 = F.in[I_CKR][crow_ * 64 + lane], x2 = F.in[I_CKR][crow_ * 64 + 32 + lane]; *(GAS unsigned*)(wsp<bf16>(F, WS_KR) + kvrow * 64 + 2 * lane) = pkbf(x1, x2); }
    { const f32x4 a = *(const GAS f32x4*)(F.in[I_CGK] + crow_ * 256 + 4 * lane);
      *(GAS unsigned long long*)(wsp<bf16>(F, WS_KG) + kvrow * 256 + 4 * lane) = (unsigned long long)pkbf(a.x, a.y) | ((unsigned long long)pkbf(a.z, a.w) << 32); }
    { const f32x4 a = *(const GAS f32x4*)(F.in[I_CGV] + crow_ * 256 + 4 * lane);
      *(GAS unsigned long long*)(wsp<bf16>(F, WS_VG) + kvrow * 256 + 4 * lane) = (unsigned long long)pkbf(a.x, a.y) | ((unsigned long long)pkbf(a.z, a.w) << 32); }
}

typedef float f32x16 __attribute__((ext_vector_type(16)));
template <int MODE>
__device__ __forceinline__ void s5_unit(Frame& F, int l, int b, int g, bool lat, int jc, LAS unsigned char* hl) {
    const int lane_ = lane_fresh();
    const int lane = lane_, n = lane & 31, hi = lane >> 5, c16 = lane & 15, q4 = lane >> 4;
    constexpr int S = S5_CH, NB = S5_NB;
    const int row0 = lat ? NCTX + b * LAT_S + jc * S5_CH : b * CTX_S;
    const float* zb = wsp<float>(F, WS_Z) + (size_t)row0 * DINP + ZU + g * 16;
    float* YP = wsp<float>(F, WS_YP) + (size_t)row0 * 512 + g * 16 + c16;
    bf16* YB = wsp<bf16>(F, WS_YB) + (size_t)row0 * 512 + g * 16 + c16;
    const size_t ldg_h = (size_t)((l * 2 + hi) * 32 + g);
    const float* ab = wsp<float>(F, WS_S5C) + (ldg_h * 64) * 2;
    const float ar0 = ab[2 * n], ai0 = ab[2 * n + 1], ar1 = ab[2 * (32 + n)], ai1 = ab[2 * (32 + n) + 1];
    bf16x8 Bop[2][2][2];
    bf16x8 Cop[2][4];
#pragma unroll
    for (int d = 0; d < 2; ++d) { const bf16* bb = wsp<bf16>(F, WS_S5C + S5C_BBAR) + (size_t)((l * 2 + d) * 32 + g) * (2 * 64 * 16);
#pragma unroll
        for (int nb = 0; nb < 2; ++nb)
#pragma unroll
            for (int ri = 0; ri < 2; ++ri) Bop[d][nb][ri] = *(const GAS bf16x8*)(bb + ((size_t)(ri * 64 + 32 * nb + n)) * 16 + 8 * hi);
        if (MODE == 0) { const bf16* cm = wsp<bf16>(F, WS_S5C + S5C_CMAT) + (size_t)((l * 2 + d) * 32 + g) * (16 * 128);
#pragma unroll
            for (int kb = 0; kb < 4; ++kb) Cop[d][kb] = *(const GAS bf16x8*)(cm + (size_t)c16 * 128 + kb * 32 + 8 * q4); } }
    float dsk = 0.f; if (MODE == 0) dsk = F.in[I_SD][(size_t)l * 512 + g * 16 + c16];
    float hr0 = 0.f, hi0 = 0.f, hr1 = 0.f, hi1 = 0.f;
    if (MODE == 0 && lat) {
        const float* st = F.in[I_ST] + ((size_t)(((b * DEPTH + l) * 2 + hi) * 32 + g) * 64) * 2; hr0 = st[2 * n]; hi0 = st[2 * n + 1]; hr1 = st[2 * (32 + n)]; hi1 = st[2 * (32 + n) + 1];
        const float* ap = wsp<float>(F, WS_S5C + S5C_APOW) + (ldg_h * 64) * 2;
        const float pr0 = ap[2 * n], pi0 = ap[2 * n + 1], pr1 = ap[2 * (32 + n)], pi1 = ap[2 * (32 + n) + 1];
        const float* sl = wsp<float>(F, WS_SL) + ((size_t)((b * 32 + g) * S5_NCH) * 2 + hi) * 128;
        for (int s = 0; s < S5_NCH - 1; ++s) { const int idx = hi ? (S5_NCH - 1 - s) : s; const bool act = hi ? (idx > jc) : (idx < jc);
            if (act) { const float* q = sl + (size_t)idx * 256; const float l0r = q[2 * n], l0i = q[2 * n + 1], l1r = q[2 * (32 + n)], l1i = q[2 * (32 + n) + 1];
                const float a = pr0 * hr0 - pi0 * hi0 + l0r, c = pr0 * hi0 + pi0 * hr0 + l0i, d = pr1 * hr1 - pi1 * hi1 + l1r, e = pr1 * hi1 + pi1 * hr1 + l1i; hr0 = a; hi0 = c; hr1 = d; hi1 = e; } }
    }
    const int rdir = (n >> 2) & 1, rstep = (n & 3) + 4 * (n >> 3);
    const int tA0 = rdir ? (S - 1 - rstep) : rstep; const int tAstep = rdir ? -16 : 16;
    const float* ap_ = zb + (size_t)tA0 * DINP + 8 * hi; const long astep = (long)tAstep * DINP;
    f32x4 ua0 = *(const GAS f32x4*)ap_, ua1 = *(const GAS f32x4*)(ap_ + 4); ap_ += astep;
    f32x4 ub0 = *(const GAS f32x4*)ap_, ub1 = *(const GAS f32x4*)(ap_ + 4); ap_ += astep;
    const f32x16 zero16 = {0.f, 0.f, 0.f, 0.f, 0.f, 0.f, 0.f, 0.f, 0.f, 0.f, 0.f, 0.f, 0.f, 0.f, 0.f, 0.f};
    const bf16x8 zfrag = {0, 0, 0, 0, 0, 0, 0, 0};
#define S5_BLOCK(IDX, U0, U1) do { const int i_ = (IDX); \
        const bool fin = (MODE == 0) && (2 * i_ >= NB); \
        bf16x8 a; { v4u w; w.x = pkbf(U0.x, U0.y); w.y = pkbf(U0.z, U0.w); w.z = pkbf(U1.x, U1.y); w.w = pkbf(U1.z, U1.w); a = __builtin_bit_cast(bf16x8, w); } \
        { const int ib_ = (i_ + 2 < NB) ? i_ + 2 : NB - 1; const float* ap_ = zb + (size_t)(tA0 + tAstep * ib_) * DINP + 8 * hi;     \
          U0 = *(const GAS f32x4*)ap_; U1 = *(const GAS f32x4*)(ap_ + 4); } \
        const bf16x8 af = rdir ? zfrag : a, abk = rdir ? a : zfrag; \
        f32x16 Dr0 = __builtin_amdgcn_mfma_f32_32x32x16_bf16(af, Bop[0][0][0], zero16, 0, 0, 0); Dr0 = __builtin_amdgcn_mfma_f32_32x32x16_bf16(abk, Bop[1][0][0], Dr0, 0, 0, 0); \
        f32x16 Di0 = __builtin_amdgcn_mfma_f32_32x32x16_bf16(af, Bop[0][0][1], zero16, 0, 0, 0); Di0 = __builtin_amdgcn_mfma_f32_32x32x16_bf16(abk, Bop[1][0][1], Di0, 0, 0, 0); \
        f32x16 Dr1 = __builtin_amdgcn_mfma_f32_32x32x16_bf16(af, Bop[0][1][0], zero16, 0, 0, 0); Dr1 = __builtin_amdgcn_mfma_f32_32x32x16_bf16(abk, Bop[1][1][0], Dr1, 0, 0, 0); \
        f32x16 Di1 = __builtin_amdgcn_mfma_f32_32x32x16_bf16(af, Bop[0][1][1], zero16, 0, 0, 0); Di1 = __builtin_amdgcn_mfma_f32_32x32x16_bf16(abk, Bop[1][1][1], Di1, 0, 0, 0); \
        LAS unsigned char* wrow = hl + (hi * 16) * 272 + n * 4; \
_Pragma("unroll") \
        for (int r = 0; r < 16; ++r) { \
            const float nr0 = ar0 * hr0 - ai0 * hi0 + Dr0[r], ni0 = ar0 * hi0 + ai0 * hr0 + Di0[r]; \
            const float nr1 = ar1 * hr1 - ai1 * hi1 + Dr1[r], ni1 = ar1 * hi1 + ai1 * hr1 + Di1[r]; \
            hr0 = nr0; hi0 = ni0; hr1 = nr1; hi1 = ni1; \
            if (MODE == 0) { *(LAS unsigned*)(wrow + r * 272) = pkbf(nr0, ni0); *(LAS unsigned*)(wrow + r * 272 + 128) = pkbf(nr1, ni1); } \
        } \
        if (MODE == 0) { \
            asm volatile("s_waitcnt lgkmcnt(0)" ::: "memory"); \
            f32x4 Y[2]; \
_Pragma("unroll") \
            for (int d = 0; d < 2; ++d) { f32x4 y = {0.f, 0.f, 0.f, 0.f}; \
_Pragma("unroll") \
                for (int kb = 0; kb < 4; ++kb) { const bf16x8 hf = *(const LAS bf16x8*)(hl + (d * 16 + c16) * 272 + (kb * 32 + 8 * q4) * 2); \
                    y = __builtin_amdgcn_mfma_f32_16x16x32_bf16(hf, Cop[d][kb], y, 0, 0, 0); } \
                Y[d] = y; } \
_Pragma("unroll") \
            for (int d = 0; d < 2; ++d) \
_Pragma("unroll") \
                for (int j = 0; j < 4; ++j) { const int tt = 16 * i_ + 4 * q4 + j; const int t = d ? (S - 1 - tt) : tt; \
                    if (!fin) YP[(size_t)t * 512] = Y[d][j]; \
                    else { const float y = pp[d][j] + Y[d][j] + dsk * uu[d][j]; YB[(size_t)t * 512] = (bf16)(pkbf(y, y) & 0xffffu); } } \
            asm volatile("" ::: "memory"); \
            { \
                if (2 * (i_ + 1) == NB) asm volatile("s_waitcnt vmcnt(0)" ::: "memory"); \
                const int in_ = (i_ + 1 < NB) ? i_ + 1 : i_; \
_Pragma("unroll") \
                for (int d = 0; d < 2; ++d) \
_Pragma("unroll") \
                    for (int j = 0; j < 4; ++j) { const int tt = 16 * in_ + 4 * q4 + j; const int t = d ? (S - 1 - tt) : tt; \
                        pp[d][j] = YP[(size_t)t * 512];     \
                        uu[d][j] = zb[(size_t)t * DINP + c16]; } } \
        } \
    } while (0)
    float pp[2][4] = {{0.f, 0.f, 0.f, 0.f}, {0.f, 0.f, 0.f, 0.f}}, uu[2][4] = {{0.f, 0.f, 0.f, 0.f}, {0.f, 0.f, 0.f, 0.f}};
    asm volatile("" : "+v"(ua0), "+v"(ua1), "+v"(ub0), "+v"(ub1));
    for (int i2 = 0; i2 < NB; i2 += 2) { S5_BLOCK(i2, ua0, ua1); S5_BLOCK(i2 + 1, ub0, ub1); }
#undef S5_BLOCK
    if (MODE == 1) { float* so = wsp<float>(F, WS_SL) + (((size_t)((b * 32 + g) * S5_NCH + jc)) * 2 + hi) * 128;
        so[2 * n] = hr0; so[2 * n + 1] = hi0; so[2 * (32 + n)] = hr1; so[2 * (32 + n) + 1] = hi1; }
    else if (!lat) { float* so = F.out + OUT_S5 + ((size_t)(((b * DEPTH + l) * 2 + hi) * 32 + g) * 64) * 2;
        so[2 * n] = hr0; so[2 * n + 1] = hi0; so[2 * (32 + n)] = hr1; so[2 * (32 + n) + 1] = hi1; }
}
__device__ __forceinline__ void post_s5_phase(Frame& F, int l) {
    int w = F.wave, v = F.vcu; asm volatile("" : "+s"(w), "+s"(v));
    LAS unsigned char* hl = F.lds + RING_OFF + w * 16384;
    { const int id = v * 8 + w; s5_unit<1>(F, l, id >> 8, (id >> 3) & 31, true, id & 7, hl); }
    if (w < 2) { const int id = v * 2 + w; s5_unit<0>(F, l, id >> 5, id & 31, false, 0, hl); }
    else { const int pw = v * 6 + (w - 2), NPW = F.G * 6;
        const int lane = lane_fresh();
        PostZ zc = post_load(F, pw, lane);
        for (int it = pw; it < MTOK; it += NPW) { const int nx = it + NPW; PostZ zn = zc; if (nx < MTOK) zn = post_load(F, nx, lane);
            post_row(F, l, it, zc, lane); zc = zn; }
        for (int k = pw; k < NLAT_REQ * PAST; k += NPW) cache_row(F, l, k >> 9, k & 511); }
}
__device__ __forceinline__ void s5_latent_phase(Frame& F, int l) {
    int w = F.wave, v = F.vcu; asm volatile("" : "+s"(w), "+s"(v));
    LAS unsigned char* hl = F.lds + RING_OFF + w * 16384;
    const int id = v * 8 + w; s5_unit<0>(F, l, id >> 8, (id >> 3) & 31, true, id & 7, hl);
}

#ifndef MLA_SDEPTH
#define MLA_SDEPTH 1
#endif
__device__ __forceinline__ void mla_unit(Frame& F, bool lat, int req, int h, int qb) {
    const size_t qrow = lat ? (size_t)NCTX + (size_t)req * LAT_S + (size_t)qb * 256 : (size_t)req * CTX_S;
    const size_t kv0 = lat ? (size_t)NCTX + (size_t)req * KVLAT : (size_t)req * CTX_S; const int seq = lat ? KVLAT : CTX_S;
    const att::bf16* Q = wsp<att::bf16>(F, WS_QM) + qrow * 1536 + h * 192;
    const att::bf16* KVp = wsp<att::bf16>(F, WS_KV) + kv0 * 2048 + h * 256;
    const att::bf16* KRp = wsp<att::bf16>(F, WS_KR) + kv0 * 64;
    att::bf16* O = wsp<att::bf16>(F, WS_MIX) + qrow * 2048 + h * 128;
    att::attn_dense_body<192, MLA_SDEPTH, 1536, 2048, 2048, 2048>(Q, KVp, KRp, KVp + 128, O, seq, F.ldsg + RING_OFF, F.wave);
}
__device__ __forceinline__ void gqa_unit(Frame& F, bool lat, int req, int h, int qb) {
    const size_t qrow = lat ? (size_t)NCTX + (size_t)req * LAT_S + (size_t)qb * 256 : (size_t)req * CTX_S;
    const size_t kv0 = lat ? (size_t)NCTX + (size_t)req * KVLAT : (size_t)req * CTX_S; const int seq = lat ? KVLAT : CTX_S;
    const att::bf16* Q = wsp<att::bf16>(F, WS_QG) + qrow * 512 + h * 128;
    const att::bf16* Kp = wsp<att::bf16>(F, WS_KG) + kv0 * 256 + (h >> 1) * 128;
    const att::bf16* Vp = wsp<att::bf16>(F, WS_VG) + kv0 * 256 + (h >> 1) * 128;
    att::bf16* O = wsp<att::bf16>(F, WS_MIX) + qrow * 2048 + 1536 + h * 128;
    att::attn_dense_body<128, 2, 512, 256, 256, 2048>(Q, Kp, nullptr, Vp, O, seq, F.ldsg + RING_OFF, F.wave);
}
__device__ __forceinline__ void attn_phase(Frame& F) {
    int v = F.vcu; asm volatile("" : "+s"(v));
#ifndef NO_MLA
    for (int k = 0; k < 2; ++k) { const int u = v + 256 * k; mla_unit(F, true, u >> 6, (u >> 3) & 7, u & 7); }
    if (v < 128) mla_unit(F, false, v >> 3, v & 7, 0);
#endif
#ifndef NO_GQA
    { const int u = v; gqa_unit(F, true, u >> 5, (u >> 3) & 3, u & 7); }
    if (v >= 128 && v < 192) { const int u = v - 128; gqa_unit(F, false, u >> 2, u & 3, 0); }
#endif
}

template <class Epi> __device__ __forceinline__ void run_gemm(Frame& F, const bf16* A, const bf16* Bt, int M, int N, int K, const Epi& E) {
    int bx_ = blockIdx.x; asm volatile("" : "+s"(bx_));
    pg8::Gemm g{A, Bt, M, N, K}; pg8::StaticOrder S; S.init(M, N, F.G, bx_);
    pg8::gemm_phase<Epi, pg8::StaticOrder, true, true>(F.lds + RING_OFF, g, S, E, F.wave);
}
__global__ void __launch_bounds__(NWAVES * 64, 2) fwd_kernel(Args args) {
    extern __shared__ __attribute__((aligned(16))) unsigned char lds[];
    Frame F;
    F.lds = (LAS unsigned char*)lds; F.ldsg = (char*)lds;
    F.MISC = (volatile LAS unsigned*)(F.lds + MISC_OFF);
    F.wave = __builtin_amdgcn_readfirstlane((int)threadIdx.x >> 6);
    F.G = gridDim.x; { const int bx = blockIdx.x; F.vcu = (F.G % 8 == 0) ? (bx % 8) * (F.G / 8) + bx / 8 : bx; }
    F.out = args.out; F.ws = args.ws;
    F.ctl = (gu32*)(args.ws + WS_CTL);
    for (int u = threadIdx.x; u < (LDS_BYTES - LDSCTL_OFF) / 4; u += NWAVES * 64) ((LAS unsigned*)(F.lds + LDSCTL_OFF))[u] = 0u;
    __syncthreads();
    (void)xcd_barrier_post((unsigned*)(F.ctl + CW_BAR), F.MISC + 8);
#define GRID_BAR() do { const __attribute__((address_space(4))) char* kp_ = (const __attribute__((address_space(4))) char*)__builtin_amdgcn_kernarg_segment_ptr(); asm volatile("" : "+s"(kp_)); \
        unsigned char* ws_ = *(unsigned char* const __attribute__((address_space(4)))*)(kp_ + 8 * (N_IN + 1)); \
        XcdBarrier b_; b_.bar = (unsigned*)(ws_ + WS_CTL) + CW_BAR; b_.x = xb_xcc_id(); b_.st = (volatile LAS unsigned*)((LAS unsigned char*)lds + MISC_OFF) + 8; b_.wv = F.wave; xcd_barrier(b_); } while (0)

    bf16* const H = wsp<bf16>(F, WS_H); bf16* const ACT = wsp<bf16>(F, WS_ACT); float* const Z = wsp<float>(F, WS_Z);
    bf16* const MIX = wsp<bf16>(F, WS_MIX);
    const float* cosm = wsp<float>(F, WS_TAB); const float* sinm = cosm + 2048 * 32;

#ifndef NO_PRO
    p0_prologue(F); GRID_BAR();
#endif
#ifdef DUP_PRO
    p0_prologue(F); GRID_BAR();
#endif
    p0b_mods(F); GRID_BAR();
    p0c_tables(F); GRID_BAR();

    const float* xa = F.in[I_XP]; const float* xb = F.in[I_XS] - (size_t)NCTX * DM;
    int xi = 0;
    bf16* const XG = H;
    float* const SSQ = wsp<float>(F, WS_SSQ); const float* const GM = wsp<float>(F, WS_GM);
    xg0_phase(F, xa, xb, GM, XG, SSQ); GRID_BAR();
    const int nlayers = args.dbg > 0 ? args.dbg : DEPTH;
    for (int l = 0; l < nlayers; ++l) {
        const float* const BIASL = wsp<float>(F, WS_BIAS) + (size_t)l * BIAS_LAYER;
        { pg8::EpiSwigluN E{ACT, FF, SSQ + (size_t)(3 * l) * MTOK, BIASL}; run_gemm(F, XG, wgt(F, l, W_GU1), MTOK, 2 * FF, DM, E); } GRID_BAR();
        { pg8::EpiResidFuse<true> E{xa, xb, xbuf(F, xi), mods(F, l, 2), XG, GM + (size_t)(3 * l + 1) * 9 * DM, SSQ + (size_t)(3 * l + 1) * MTOK};
          run_gemm(F, ACT, wgt(F, l, W_D1), MTOK, DM, FF, E); xa = xb = xbuf(F, xi); ++xi; } GRID_BAR();
        { pg8::EpiF32N E{Z, DINP, SSQ + (size_t)(3 * l + 1) * MTOK, BIASL + BIAS_WIN}; run_gemm(F, XG, wgt(F, l, W_IN), MTOK, DINP, DM, E); } GRID_BAR();
#ifndef NO_S5
        post_s5_phase(F, l); GRID_BAR();
#endif
#ifdef DUP_POST
        post_s5_phase(F, l); GRID_BAR();
#endif
        s5_latent_phase(F, l); __syncthreads();
        { pg8::EpiQ E{wsp<bf16>(F, WS_QM), cosm, sinm}; run_gemm(F, wsp<bf16>(F, WS_QN), wgt(F, l, W_UQ), MTOK, 1536, 512, E); }
        { pg8::EpiBf16 E{wsp<bf16>(F, WS_KV), 2048}; run_gemm(F, wsp<bf16>(F, WS_CKV), wgt(F, l, W_UKV), MKV, 2048, 256, E); } GRID_BAR();
#ifndef NO_ATT
        attn_phase(F);
#endif
#ifdef DUP_ATT
        attn_phase(F);
#endif
        { pg8::EpiGlu E{wsp<bf16>(F, WS_YB), F.in[I_BGLU] + (size_t)l * 512, MIX, DM, 1024}; run_gemm(F, wsp<bf16>(F, WS_YB), wgt(F, l, W_GLU), MTOK, 512, 512, E); } GRID_BAR();
        { pg8::EpiResidFuse<false> E{xa, xb, xbuf(F, xi), mods(F, l, 5), XG, GM + (size_t)(3 * l + 2) * 9 * DM, SSQ + (size_t)(3 * l + 2) * MTOK};
          run_gemm(F, MIX, wgt(F, l, W_OUT), MTOK, DM, DM, E); xa = xb = xbuf(F, xi); ++xi; } GRID_BAR();
        { pg8::EpiSwigluN E{ACT, FF, SSQ + (size_t)(3 * l + 2) * MTOK, BIASL + BIAS_GU2}; run_gemm(F, XG, wgt(F, l, W_GU2), MTOK, 2 * FF, DM, E); } GRID_BAR();
        { const bool more = (l + 1 < nlayers);
          pg8::EpiResidFuse<true> E{xa, xb, xbuf(F, xi), mods(F, l, 8), more ? XG : nullptr, GM + (size_t)(3 * (l + 1)) * 9 * DM, SSQ + (size_t)(3 * (l + 1)) * MTOK};
          run_gemm(F, ACT, wgt(F, l, W_D2), MTOK, DM, FF, E); xa = xb = xbuf(F, xi); ++xi; } GRID_BAR();
    }
    finalnorm_phase(F, xa, F.in[I_NFIN], F.out + OUT_Y);
#undef GRID_BAR
}

extern "C" void kernel_launch(void* const* d_in, const int* in_sizes, int n_in, void* d_out, int out_size, void* d_ws, size_t ws_size, hipStream_t stream) {
    static int grid = 0;
    if (grid == 0) {
        if (n_in != N_IN || (size_t)out_size != OUT_END || ws_size < WS_END) { fprintf(stderr, "kernel_launch: shape mismatch: n_in %d out %d ws %zu (need %d, %zu, >= %zu)\n", n_in, out_size, ws_size, (int)N_IN, (size_t)OUT_END, (size_t)WS_END); grid = -1; return; }
        int dev = 0, cus = 0, per_cu = 0;
        if (hipGetDevice(&dev) != hipSuccess || hipDeviceGetAttribute(&cus, hipDeviceAttributeMultiprocessorCount, dev) != hipSuccess) { fprintf(stderr, "kernel_launch: device query failed\n"); grid = -1; return; }
        if (hipFuncSetAttribute((const void*)fwd_kernel, hipFuncAttributeMaxDynamicSharedMemorySize, LDS_BYTES) != hipSuccess) { fprintf(stderr, "kernel_launch: hipFuncSetAttribute failed\n"); grid = -1; return; }
        if (hipOccupancyMaxActiveBlocksPerMultiprocessor(&per_cu, (const void*)fwd_kernel, NWAVES * 64, LDS_BYTES) != hipSuccess || per_cu < 1)
            fprintf(stderr, "kernel_launch: note: occupancy query reports %d workgroups per CU\n", per_cu);
        (void)hipGetLastError();
        grid = cus;
        if (grid != 256) { fprintf(stderr, "kernel_launch: built for 256 CUs, device has %d\n", cus); grid = -1; return; }
    }
    if (grid < 0) return;
    if (hipMemsetAsync((char*)d_ws + WS_CTL, 0, CTL_ZERO_BYTES, stream) != hipSuccess || hipMemsetAsync((char*)d_ws + WS_SSQ, 0, SSQ_BYTES, stream) != hipSuccess) { fprintf(stderr, "kernel_launch: memset failed\n"); return; }
    Args a{};
    for (int i = 0; i < N_IN; ++i) a.in[i] = (const float*)d_in[i];
    a.out = (float*)d_out; a.ws = (unsigned char*)d_ws; a.dbg = 0; a.pad = 0;
    hipLaunchKernelGGL(fwd_kernel, dim3(grid), dim3(NWAVES * 64), LDS_BYTES, stream, a);
    const hipError_t le = hipPeekAtLastError();
    if (le != hipSuccess) fprintf(stderr, "kernel_launch: launch failed: %s\n", hipGetErrorName(le));
#if DBG_CHECK
    dbg_launch(a, stream);
#endif
}
```
